# Optimizing an MI355X kernel written in HIP

```python
import jax
import jax.numpy as jnp
from jax import lax
import numpy as np

D_MODEL = 1024
BATCH = 16
SEQ = 2048
DEPTH = 1

SWA_HEAD_DIM = 64
SWA_Q_HEADS = 8
SWA_KV_HEADS = 2
SWA_GROUP = SWA_Q_HEADS // SWA_KV_HEADS
WINDOW = 128
BAND_BLOCK = 128
RET_HEADS = 4
RET_QK_DIM = 128
RET_V_DIM = 256
RET_CHUNK = 128
ROPE_BASE = 10000.0
MEM_LEN = 256
MEM_HEADS = 4
MEM_HEAD_DIM = 128
N_BRANCH = 3
N_EXPERTS = 32
TOP_K = 4
D_FF = 1024
SWIGLU_LIMIT = 7.0
SWIGLU_ALPHA = 1.702
EPS = 1e-6
NEG_INF = -1e30

SWA_Q_W = SWA_Q_HEADS * SWA_HEAD_DIM
SWA_KV_W = SWA_KV_HEADS * SWA_HEAD_DIM
RET_QK_W = RET_HEADS * RET_QK_DIM
RET_V_W = RET_HEADS * RET_V_DIM
MEM_W = MEM_HEADS * MEM_HEAD_DIM
IN_SIZES = (SWA_Q_W, SWA_KV_W, SWA_KV_W, RET_QK_W, RET_QK_W, RET_V_W, RET_V_W, MEM_W, N_BRANCH * D_MODEL)
IN_WIDTH = sum(IN_SIZES)

kernel_name = "hybrid_swa_retention_memory_moe_block"


def rms_norm(x, w):
    xf = x.astype(jnp.float32)
    y = xf * lax.rsqrt(jnp.mean(xf * xf, axis=-1, keepdims=True) + EPS)
    return (y * w.astype(jnp.float32)).astype(x.dtype)


def head_layer_norm(t, w):
    mu = jnp.mean(t, axis=-1, keepdims=True)
    tc = t - mu
    var = jnp.mean(tc * tc, axis=-1, keepdims=True)
    return tc * lax.rsqrt(var + EPS) * w.astype(jnp.float32)


def split_cols(z, sizes):
    outs = []
    off = 0
    for s in sizes:
        outs.append(z[..., off:off + s])
        off += s
    return outs


def rotary(t):
    S, d = t.shape[1], t.shape[-1]
    half = d // 2
    inv = 1.0 / (ROPE_BASE ** (jnp.arange(0, half, dtype=jnp.float32) / half))
    ang = jnp.arange(S, dtype=jnp.float32)[:, None] * inv[None, :]
    cos = jnp.cos(ang)[None, :, None, :]
    sin = jnp.sin(ang)[None, :, None, :]
    tf = t.astype(jnp.float32)
    t1, t2 = tf[..., :half], tf[..., half:]
    return jnp.concatenate([t1 * cos - t2 * sin, t1 * sin + t2 * cos], axis=-1).astype(t.dtype)


def sliding_window_attention(q, k, v, sinks):
    B, S = q.shape[0], q.shape[1]
    nb = S // BAND_BLOCK
    qb = q.reshape(B, nb, BAND_BLOCK, SWA_KV_HEADS, SWA_GROUP, SWA_HEAD_DIM)

    def band(t):
        tp = jnp.pad(t, ((0, 0), (BAND_BLOCK, 0), (0, 0), (0, 0)))
        tb = tp.reshape(B, nb + 1, BAND_BLOCK, SWA_KV_HEADS, SWA_HEAD_DIM)
        return jnp.concatenate([tb[:, :-1], tb[:, 1:]], axis=2)

    kb, vb = band(k), band(v)
    scores = jnp.einsum('bnqhgd,bnkhd->bnhgqk', qb, kb,
                        preferred_element_type=jnp.float32) * (SWA_HEAD_DIM ** -0.5)
    qi = jnp.arange(BAND_BLOCK)[:, None]
    kj = jnp.arange(2 * BAND_BLOCK)[None, :]
    diff = BAND_BLOCK + qi - kj
    in_win = (diff >= 0) & (diff < WINDOW)
    not_pad = (jnp.arange(nb) > 0)[:, None, None] | (kj >= BAND_BLOCK)[None]
    mask = in_win[None] & not_pad
    scores = jnp.where(mask[None, :, None, None], scores, NEG_INF)
    sink = jnp.broadcast_to(sinks.astype(jnp.float32).reshape(1, 1, SWA_KV_HEADS, SWA_GROUP, 1, 1),
                            scores.shape[:-1] + (1,))
    probs = jax.nn.softmax(jnp.concatenate([scores, sink], axis=-1), axis=-1)[..., :-1]
    out = jnp.einsum('bnhgqk,bnkhd->bnqhgd', probs.astype(v.dtype), vb)
    return out.reshape(B, S, SWA_Q_HEADS * SWA_HEAD_DIM)


def retention(q, k, v):
    B, S = q.shape[0], q.shape[1]
    L = RET_CHUNK
    nc = S // L
    log_g = jnp.log1p(-(2.0 ** (-5.0 - jnp.arange(RET_HEADS, dtype=jnp.float32))))
    pos = jnp.arange(L, dtype=jnp.float32)
    diff = pos[:, None] - pos[None, :]
    decay_mask = jnp.where(diff[None] >= 0,
                           jnp.exp(jnp.maximum(diff, 0.0)[None] * log_g[:, None, None]), 0.0)
    q_decay = jnp.exp((pos[None, :] + 1.0) * log_g[:, None])[..., None]
    k_decay = jnp.exp((L - 1.0 - pos[None, :]) * log_g[:, None])[..., None]
    chunk_decay = jnp.exp(L * log_g)[:, None, None]

    def chunks(t):
        d = t.shape[-1]
        return t.astype(jnp.float32).reshape(B, nc, L, RET_HEADS, d).transpose(1, 0, 3, 2, 4)

    qc, kc, vc = chunks(q), chunks(k), chunks(v)

    def step(state, inp):
        qi, ki, vi = inp
        inner = jnp.einsum('bhld,bhmd->bhlm', qi, ki) * decay_mask[None]
        o = jnp.einsum('bhlm,bhme->bhle', inner, vi) + \
            jnp.einsum('bhld,bhde->bhle', qi * q_decay[None], state)
        state = state * chunk_decay[None] + jnp.einsum('bhld,bhle->bhde', ki * k_decay[None], vi)
        return state, o

    state0 = jnp.zeros((B, RET_HEADS, RET_QK_DIM, RET_V_DIM), jnp.float32)
    _, o = lax.scan(step, state0, (qc, kc, vc))
    return o.transpose(1, 0, 3, 2, 4).reshape(B, S, RET_HEADS, RET_V_DIM)


def memory_attention(q, mk, mv):
    B, S = q.shape[0], q.shape[1]
    s = jnp.einsum('bshd,bmhd->bhsm', q, mk, preferred_element_type=jnp.float32) * (MEM_HEAD_DIM ** -0.5)
    p = jax.nn.softmax(s, axis=-1)
    o = jnp.einsum('bhsm,bmhd->bshd', p.astype(mv.dtype), mv)
    return o.reshape(B, S, MEM_W)


def routed_experts(h, w_router, b_router, w_up, b_up, w_down, b_down):
    B, S, D = h.shape
    T = B * S
    ht = h.reshape(T, D)
    logits = (ht @ w_router + b_router).astype(jnp.float32)
    top_vals, top_idx = lax.top_k(logits, TOP_K)
    gate = jax.nn.softmax(top_vals, axis=-1)
    flat_e = top_idx.reshape(-1)
    order = jnp.argsort(flat_e)
    e_sorted = flat_e[order]
    tok = order // TOP_K
    xs = ht[tok]
    group_sizes = jnp.bincount(flat_e, length=N_EXPERTS).astype(jnp.int32)
    hid = lax.ragged_dot(xs, w_up, group_sizes) + b_up[e_sorted]
    x_glu = jnp.minimum(hid[:, 0::2], SWIGLU_LIMIT)
    x_lin = jnp.clip(hid[:, 1::2], -SWIGLU_LIMIT, SWIGLU_LIMIT)
    act = x_glu * jax.nn.sigmoid(SWIGLU_ALPHA * x_glu) * (x_lin + 1.0)
    out = lax.ragged_dot(act, w_down, group_sizes) + b_down[e_sorted]
    out = out * gate.reshape(-1)[order][:, None].astype(out.dtype)
    y = jnp.zeros_like(ht).at[tok].add(out)
    return y.reshape(B, S, D)


def setup_inputs(seed: int = 0) -> dict:
    key = jax.random.key(seed)
    ks = jax.random.split(key, 23)
    f32 = jnp.float32
    L, D = DEPTH, D_MODEL

    def nrm(k, shape, scale):
        return jax.random.normal(k, shape, f32) * scale

    def gain(k, shape):
        return 1.0 + 0.05 * jax.random.normal(k, shape, f32)

    return {
        'x': nrm(ks[0], (BATCH, SEQ, D), 1.0),
        'mem': nrm(ks[1], (BATCH, MEM_LEN, D), 1.0),
        'mix_norm_w': gain(ks[2], (L, D)),
        'mem_norm_w': gain(ks[3], (L, D)),
        'w_in': nrm(ks[4], (L, D, IN_WIDTH), D ** -0.5),
        'swa_q_norm_w': gain(ks[5], (L, SWA_HEAD_DIM)),
        'swa_k_norm_w': gain(ks[6], (L, SWA_HEAD_DIM)),
        'swa_sinks': nrm(ks[7], (L, SWA_Q_HEADS), 0.5),
        'ret_norm_w': gain(ks[8], (L, RET_V_W)),
        'w_mem_kv': nrm(ks[9], (L, D, 2 * MEM_W), D ** -0.5),
        'mem_q_norm_w': gain(ks[10], (L, MEM_HEAD_DIM)),
        'mem_k_norm_w': gain(ks[11], (L, MEM_HEAD_DIM)),
        'w_br_swa': nrm(ks[12], (L, SWA_Q_W, D), SWA_Q_W ** -0.5),
        'w_br_ret': nrm(ks[13], (L, RET_V_W, D), RET_V_W ** -0.5),
        'w_br_mem': nrm(ks[14], (L, MEM_W, D), MEM_W ** -0.5),
        'w_out': nrm(ks[15], (L, D, D), D ** -0.5),
        'ffn_norm_w': gain(ks[16], (L, D)),
        'w_router': nrm(ks[17], (L, D, N_EXPERTS), D ** -0.5),
        'b_router': nrm(ks[18], (L, N_EXPERTS), 0.01),
        'w_up': nrm(ks[19], (L, N_EXPERTS, D, 2 * D_FF), D ** -0.5),
        'b_up': nrm(ks[20], (L, N_EXPERTS, 2 * D_FF), 0.01),
        'w_down': nrm(ks[21], (L, N_EXPERTS, D_FF, D), D_FF ** -0.5),
        'b_down': nrm(ks[22], (L, N_EXPERTS, D), 0.01),
    }


def reference(x, mem, mix_norm_w, mem_norm_w, w_in, swa_q_norm_w, swa_k_norm_w, swa_sinks,
              ret_norm_w, w_mem_kv, mem_q_norm_w, mem_k_norm_w, w_br_swa, w_br_ret, w_br_mem,
              w_out, ffn_norm_w, w_router, b_router, w_up, b_up, w_down, b_down):
    B, S, D = x.shape
    for l in range(DEPTH):
        h = rms_norm(x, mix_norm_w[l])
        z = h @ w_in[l]
        sq, sk, sv, rq, rk, rv, rg, mq, zg = split_cols(z, IN_SIZES)

        sq = rms_norm(sq.reshape(B, S, SWA_Q_HEADS, SWA_HEAD_DIM), swa_q_norm_w[l])
        sk = rms_norm(sk.reshape(B, S, SWA_KV_HEADS, SWA_HEAD_DIM), swa_k_norm_w[l])
        sv = sv.reshape(B, S, SWA_KV_HEADS, SWA_HEAD_DIM)
        o_swa = sliding_window_attention(sq, sk, sv, swa_sinks[l])

        rq = rotary(rq.reshape(B, S, RET_HEADS, RET_QK_DIM))
        rk = rotary(rk.reshape(B, S, RET_HEADS, RET_QK_DIM)) * (RET_QK_DIM ** -0.5)
        rv = rv.reshape(B, S, RET_HEADS, RET_V_DIM)
        o_ret = head_layer_norm(retention(rq, rk, rv), ret_norm_w[l].reshape(RET_HEADS, RET_V_DIM))
        o_ret = jax.nn.silu(rg) * o_ret.reshape(B, S, RET_V_W).astype(x.dtype)

        m = rms_norm(mem, mem_norm_w[l])
        mk, mv = split_cols(m @ w_mem_kv[l], (MEM_W, MEM_W))
        M = mem.shape[1]
        mq = rms_norm(mq.reshape(B, S, MEM_HEADS, MEM_HEAD_DIM), mem_q_norm_w[l])
        mk = rms_norm(mk.reshape(B, M, MEM_HEADS, MEM_HEAD_DIM), mem_k_norm_w[l])
        mv = mv.reshape(B, M, MEM_HEADS, MEM_HEAD_DIM)
        o_mem = memory_attention(mq, mk, mv)

        gates = jax.nn.sigmoid(zg).reshape(B, S, N_BRANCH, D)
        merged = (gates[:, :, 0] * (o_swa @ w_br_swa[l])
                  + gates[:, :, 1] * (o_ret @ w_br_ret[l])
                  + gates[:, :, 2] * (o_mem @ w_br_mem[l]))
        x = x + merged @ w_out[l]

        h2 = rms_norm(x, ffn_norm_w[l])
        x = x + routed_experts(h2, w_router[l], b_router[l], w_up[l], b_up[l], w_down[l], b_down[l])
    return x
```

```cpp
#include <hip/hip_runtime.h>
#include <cstdio>
#include <cstdint>

#define GAS __attribute__((address_space(1)))
#define LAS __attribute__((address_space(3)))
typedef unsigned short bf16;
typedef unsigned v4u __attribute__((ext_vector_type(4)));
typedef unsigned v2u __attribute__((ext_vector_type(2)));
typedef float f32x4 __attribute__((ext_vector_type(4)));
typedef float f32x2 __attribute__((ext_vector_type(2)));
typedef float f32x16 __attribute__((ext_vector_type(16)));
typedef short bf16x8 __attribute__((ext_vector_type(8)));
typedef short s16x4 __attribute__((ext_vector_type(4)));
typedef GAS unsigned gu32;
#define RLX_AGENT __ATOMIC_RELAXED, __HIP_MEMORY_SCOPE_AGENT
#define LDS_WAIT() asm volatile("s_waitcnt lgkmcnt(0)" ::: "memory")
#define VM_WAIT() asm volatile("s_waitcnt vmcnt(0)" ::: "memory")

constexpr int D = 1024, BATCH = 16, SEQ = 2048, T = BATCH * SEQ;
constexpr int MEMLEN = 256, TM = BATCH * MEMLEN;
constexpr int INW = 7424;
constexpr int C_SQ = 0, C_SK = 512, C_SV = 640, C_RQ = 768, C_RK = 1280, C_RV = 1792, C_RG = 2816, C_MQ = 3840, C_ZG = 4352;
constexpr int NE = 32, TOPK = 4, DFF = 1024;
constexpr int OC = 2048;
constexpr float EPS = 1e-6f;
constexpr int LCAP = T;
constexpr int ACT_ROWS = T * TOPK + NE * 256;

constexpr size_t MiB = 1u << 20;
constexpr size_t WS_CTL = 0, CTL_ZERO_BYTES = 1 * MiB;
constexpr size_t WS_ROPE = 1 * MiB;
constexpr size_t WS_WIN = 2 * MiB;
constexpr size_t WS_WMKV = 17 * MiB;
constexpr size_t WS_WBR = 19 * MiB;
constexpr size_t WS_WOUT = 23 * MiB;
constexpr size_t WS_WR = 25 * MiB;
constexpr size_t WS_WUP = 26 * MiB;
constexpr size_t WS_WDN = 154 * MiB;
constexpr size_t WS_H = 218 * MiB;
constexpr size_t WS_MB = 282 * MiB;
constexpr size_t WS_MKV = 290 * MiB;
constexpr size_t WS_Z = 298 * MiB;
constexpr size_t WS_OC = 762 * MiB;
constexpr size_t WS_ST = 890 * MiB;
constexpr size_t WS_LIST = 954 * MiB;
constexpr size_t WS_GATE = 958 * MiB;
constexpr size_t WS_ACT = 298 * MiB;
constexpr size_t WS_Y = 570 * MiB;
constexpr size_t WS_END = 960 * MiB;
static_assert(WS_ACT + (size_t)ACT_ROWS * 1024 * 2 <= WS_Y && WS_Y + (size_t)T * 4 * 1024 * 2 <= WS_ST + 64 * MiB, "overlay map");
constexpr int CW_TMO = 0, CW_CODE = 1;
constexpr int CW_CNT = 64;
constexpr int CW_BAR = 4096;

constexpr int SCR_BYTES = 147456;
constexpr int MISC_OFF = SCR_BYTES;
constexpr int LDS_BYTES = SCR_BYTES + 1024;

__device__ __forceinline__ unsigned cvt_pk_bf16(float lo, float hi) { unsigned r; asm volatile("v_cvt_pk_bf16_f32 %0, %1, %2" : "=v"(r) : "v"(lo), "v"(hi)); return r; }
__device__ __forceinline__ float bf_lo(unsigned w) { return __builtin_bit_cast(float, w << 16); }
__device__ __forceinline__ float bf_hi(unsigned w) { return __builtin_bit_cast(float, w & 0xffff0000u); }
__device__ __forceinline__ float wave_sum(float v) {
#pragma unroll
    for (int o = 1; o < 64; o <<= 1) v += __shfl_xor(v, o);
    return v;
}
__device__ __forceinline__ float sigmoidf_(float x) { return 1.f / (1.f + __expf(-x)); }

#define XB_TMO      128
#define XB_XCNT(j)  (256  + 64 * (j))
#define XB_XSUB(j)  (1280 + 64 * (j))
#define XB_XGEN(j)  (2304 + 64 * (j))
#define XB_TOP      3328
#define XB_TOPGEN   3392
#define XCD_BAR_WORDS 3456
#define XB_SPIN_CAP (1u << 18)
__device__ __forceinline__ unsigned xb_ld(unsigned* p)              { return __hip_atomic_load(p, __ATOMIC_RELAXED, __HIP_MEMORY_SCOPE_AGENT); }
__device__ __forceinline__ unsigned xb_add(unsigned* p, unsigned v) { return __hip_atomic_fetch_add(p, v, __ATOMIC_RELAXED, __HIP_MEMORY_SCOPE_AGENT); }
__device__ __forceinline__ unsigned xb_xcc_id() { return (unsigned)__builtin_amdgcn_s_getreg((3 << 11) | 20) & 0xFu; }
#define XB_SPIN(cond, bar) do { unsigned _sp = 0; while (cond) { __builtin_amdgcn_s_sleep(1); \
    if ((++_sp & 255u) == 0u) { if (xb_ld(&(bar)[XB_TMO])) break; if (_sp > XB_SPIN_CAP) { atomicAdd(&(bar)[XB_TMO], 1u); break; } } } } while (0)
struct XcdBarrier { unsigned* bar; unsigned x; volatile LAS unsigned* st; };
__device__ __forceinline__ XcdBarrier xcd_barrier_post(unsigned* bar, volatile LAS unsigned* st) {
    XcdBarrier b; b.bar = bar; b.x = xb_xcc_id(); b.st = st;
    if (threadIdx.x == 0) (void)xb_add(&bar[XB_XCNT(b.x)], 1u);
    return b;
}
__device__ __forceinline__ void xcd_barrier_complete(unsigned* bar, unsigned x, unsigned& nloc, unsigned& nx) {
    const unsigned G = gridDim.x * gridDim.y * gridDim.z;
    unsigned sum, cnt, mine, sp = 0u;
    for (;;) {
        sum = 0u; cnt = 0u; mine = 0u;
#pragma unroll
        for (unsigned j = 0; j < 16; ++j) { const unsigned c = xb_ld(&bar[XB_XCNT(j)]); sum += c; cnt += (c > 0u) ? 1u : 0u; mine = (j == x) ? c : mine; }
        if (sum == G) break;
        __builtin_amdgcn_s_sleep(1);
        if ((++sp & 255u) == 0u) { if (xb_ld(&bar[XB_TMO])) break; if (sp > XB_SPIN_CAP) { atomicAdd(&bar[XB_TMO], 1u); break; } }
    }
    nloc = mine > 0u ? mine : 1u; nx = cnt > 0u ? cnt : 1u;
}
__device__ __forceinline__ void xcd_barrier(const XcdBarrier& b) {
    asm volatile("s_waitcnt vmcnt(0)" ::: "memory");
    __syncthreads();
    if (threadIdx.x == 0) {
        unsigned* bar = b.bar;
        __builtin_amdgcn_s_waitcnt(0);
        unsigned nloc = b.st[0], nx = b.st[1];
        if (nloc == 0u) { xcd_barrier_complete(bar, b.x, nloc, nx); b.st[0] = nloc; b.st[1] = nx; }
        const unsigned old = xb_add(&bar[XB_XSUB(b.x)], 1u);
        const unsigned gen = old / nloc;
        if (old + 1u == (gen + 1u) * nloc) {
            __builtin_amdgcn_fence(__ATOMIC_RELEASE, "agent");
            asm volatile("s_waitcnt vmcnt(0)" ::: "memory");
            const unsigned og = xb_add(&bar[XB_TOP], 1u);
            const unsigned tg = og / nx;
            if (og + 1u == (tg + 1u) * nx) xb_add(&bar[XB_TOPGEN], 1u);
            else XB_SPIN(xb_ld(&bar[XB_TOPGEN]) == tg, bar);
            __builtin_amdgcn_fence(__ATOMIC_ACQUIRE, "agent");
            xb_add(&bar[XB_XGEN(b.x)], 1u);
            asm volatile("s_waitcnt vmcnt(0)" ::: "memory");
        } else {
            XB_SPIN(xb_ld(&bar[XB_XGEN(b.x)]) == gen, bar);
            __builtin_amdgcn_fence(__ATOMIC_ACQUIRE, "agent");
            asm volatile("s_waitcnt vmcnt(0)" ::: "memory");
        }
    }
    __syncthreads();
}

namespace pg8 {
constexpr int BM = 256, BK = 64, HALF = 128, HTB = HALF * BK * 2, STAGE_BYTES = 8 * HTB, NXCD = 8, WGM = 8;
__device__ __forceinline__ int lds_byte(int r, int c) { const int st = (r >> 4) * 2 + (c >> 5), rr = r & 15, cc = c & 31, ob = rr * 64 + cc * 2; return st * 1024 + (ob ^ (((ob >> 9) & 1) << 5)); }
__device__ __forceinline__ void stage_rc(int b, int& R, int& C) { const int st = b / 1024, sb = b % 1024, swz = sb ^ (((sb >> 9) & 1) << 5); R = (st >> 1) * 16 + swz / 64; C = (st & 1) * 32 + (swz % 64) / 2; }
__device__ __forceinline__ int perm32(int rho) { const int n = rho >> 4, i = rho & 15; return 8 * (i >> 2) + 4 * n + (i & 3); }
struct Unit { int pm, pn, e, x; };
__device__ __forceinline__ bool static_order(int L, int nM, int nN, int& pm, int& pn) {
    const int nwg = nM * nN; if (L >= nwg) return false;
    int wgid = L; { const int q = nwg / NXCD, r = nwg % NXCD, xcd = wgid % NXCD, off = wgid / NXCD; wgid = (xcd < r ? xcd * (q + 1) : r * (q + 1) + (xcd - r) * q) + off; }
    const int nig = WGM * nN, gid = wgid / nig, fm = gid * WGM, gsz = (nM - fm) < WGM ? (nM - fm) : WGM;
    pm = fm + ((wgid % nig) % gsz); pn = (wgid % nig) / gsz; return true;
}
template <class P>
__device__ __forceinline__ void gemm_phase(LAS unsigned char* lds, const P& p) {
    const int tid = threadIdx.x, wid = __builtin_amdgcn_readfirstlane(tid >> 6), lane = tid & 63, wr = wid >> 2, wc = wid & 3, fr = lane & 15, fq = lane >> 4;
    const int K = p.K, nt = K / BK;
    unsigned voffB[2], vA[2][2], vN[2][2];
    const size_t kstep = (size_t)(BK * 2);
    const size_t hstep = (size_t)HALF * K * 2;
#pragma unroll
    for (int i = 0; i < 2; ++i) { int R, C; stage_rc(tid * 16 + i * 8192, R, C); const int Rb = P::PERM ? ((R & ~31) + perm32(R & 31)) : R;
        voffB[i] = (unsigned)(Rb * K + C) * 2u; vA[0][i] = (unsigned)(R * K + C) * 2u; vA[1][i] = vA[0][i] + (unsigned)hstep; }
    const unsigned ldsw = (unsigned)wid * 1024u;
    const int aoff = lds_byte(wr * 64 + fr, fq * 8), boff = lds_byte(wc * 32 + fr, fq * 8);
#define PG8_SA(b, h) (((b) * 2 + (h)) * HTB)
#define PG8_SB(b, h) ((4 + (b) * 2 + (h)) * HTB)
#define PG8_STAGE(bufoff, gbase, voff) do { _Pragma("unroll") for (int _i = 0; _i < 2; ++_i) \
        __builtin_amdgcn_global_load_lds((const unsigned*)((const char*)(gbase) + (voff)[_i]), (LAS unsigned*)(lds + (bufoff) + ldsw + _i * 8192), 16, 0, 0); } while (0)
#define PG8_LDA(dst, b, h) do { _Pragma("unroll") for (int m = 0; m < 4; ++m) _Pragma("unroll") for (int k = 0; k < 2; ++k) dst[m][k] = *(const LAS bf16x8*)(lds + PG8_SA(b, h) + aoff + m * 2048 + k * 1024); } while (0)
#define PG8_LDB(dst, b, h) do { _Pragma("unroll") for (int n = 0; n < 2; ++n) _Pragma("unroll") for (int k = 0; k < 2; ++k) dst[n][k] = *(const LAS bf16x8*)(lds + PG8_SB(b, h) + boff + n * 2048 + k * 1024); } while (0)
#define PG8_MMA(ai, bj, At, Bt) do { __builtin_amdgcn_s_setprio(1); _Pragma("unroll") for (int m = 0; m < 4; ++m) _Pragma("unroll") for (int n = 0; n < 2; ++n) _Pragma("unroll") for (int k = 0; k < 2; ++k) \
        acc[ai][bj][m][n] = __builtin_amdgcn_mfma_f32_16x16x32_bf16(Bt[n][k], At[m][k], acc[ai][bj][m][n], 0, 0, 0); __builtin_amdgcn_s_setprio(0); } while (0)
#define PG8_WAIT_V(n) asm volatile("s_waitcnt vmcnt(" #n ")" ::: "memory")
#define PG8_WAIT_L(n) asm volatile("s_waitcnt lgkmcnt(" #n ")" ::: "memory")
#define PG8_BAR __builtin_amdgcn_s_barrier()
#define PG8_SCHED __builtin_amdgcn_sched_barrier(0)
    Unit cur, nxt; int ui = 0;
    if (!p.next(0, cur)) return;
    f32x4 acc[2][2][4][2];
#pragma unroll
    for (int a = 0; a < 2; ++a)
#pragma unroll
        for (int b = 0; b < 2; ++b)
#pragma unroll
            for (int m = 0; m < 4; ++m)
#pragma unroll
                for (int n = 0; n < 2; ++n) acc[a][b][m][n] = (f32x4){0.f, 0.f, 0.f, 0.f};
    bf16x8 At[4][2], B0[2][2], B1[2][2];
    const char* cA = p.a_base(cur); const char* cB = p.b_base(cur);
    if constexpr (P::GATHER) { p.a_off(cur, tid, vA); asm volatile("" : "+v"(vA[0][0]), "+v"(vA[0][1]), "+v"(vA[1][0]), "+v"(vA[1][1])); }
    PG8_STAGE(PG8_SB(0, 0), cB, voffB); PG8_STAGE(PG8_SB(0, 1), cB + hstep, voffB); PG8_STAGE(PG8_SA(0, 0), cA, vA[0]); PG8_STAGE(PG8_SA(0, 1), cA, vA[1]);
    if (wr == 1) PG8_BAR;
    PG8_WAIT_V(2); PG8_BAR;
    PG8_STAGE(PG8_SB(1, 0), cB + kstep, voffB); PG8_STAGE(PG8_SA(1, 0), cA + kstep, vA[0]); PG8_STAGE(PG8_SB(1, 1), cB + hstep + kstep, voffB);
    PG8_WAIT_V(6); PG8_BAR;
    for (;;) {
        const bool has_next = p.next(ui + 1, nxt);
        const char* nA = has_next ? p.a_base(nxt) : cA; const char* nB = has_next ? p.b_base(nxt) : cB;
        if constexpr (P::GATHER) {
            if (has_next) p.a_off(nxt, tid, vN); else { vN[0][0] = vA[0][0]; vN[0][1] = vA[0][1]; vN[1][0] = vA[1][0]; vN[1][1] = vA[1][1]; }
            asm volatile("" : "+v"(vN[0][0]), "+v"(vN[0][1]), "+v"(vN[1][0]), "+v"(vN[1][1]));
        }
        for (int t = 0; t < nt; t += 2) {
            const bool last = (t == nt - 2);
            if constexpr (P::HAS_MID) p.mid(acc, cur, t, wr, wc, fr, fq);
            const char* a1 = cA + (size_t)(t + 1) * kstep;
            const char* a2 = last ? nA : cA + (size_t)(t + 2) * kstep; const char* b2 = last ? nB : cB + (size_t)(t + 2) * kstep;
            const char* a3 = a2 + kstep; const char* b3 = b2 + kstep;
            unsigned o0[2], o1[2];
            if constexpr (P::GATHER) { o0[0] = last ? vN[0][0] : vA[0][0]; o0[1] = last ? vN[0][1] : vA[0][1]; o1[0] = last ? vN[1][0] : vA[1][0]; o1[1] = last ? vN[1][1] : vA[1][1]; }
            else { o0[0] = vA[0][0]; o0[1] = vA[0][1]; o1[0] = vA[1][0]; o1[1] = vA[1][1]; }
            PG8_LDB(B0, 0, 0); PG8_LDB(B1, 0, 1); PG8_SCHED; PG8_LDA(At, 0, 0); PG8_STAGE(PG8_SA(1, 1), a1, vA[1]);
            PG8_WAIT_V(8); PG8_WAIT_L(0); PG8_BAR; PG8_MMA(0, 0, At, B0); PG8_MMA(0, 1, At, B1); PG8_BAR; PG8_SCHED;
            PG8_LDA(At, 0, 1); PG8_STAGE(PG8_SB(0, 0), b2, voffB); PG8_STAGE(PG8_SB(0, 1), b2 + hstep, voffB); PG8_STAGE(PG8_SA(0, 0), a2, o0);
            PG8_WAIT_V(8); PG8_WAIT_L(0); PG8_BAR; PG8_MMA(1, 0, At, B0); PG8_MMA(1, 1, At, B1); PG8_BAR; PG8_SCHED;
            PG8_LDB(B0, 1, 0); PG8_LDB(B1, 1, 1); PG8_SCHED; PG8_LDA(At, 1, 0); PG8_STAGE(PG8_SA(0, 1), a2, o1);
            PG8_WAIT_V(8); PG8_WAIT_L(0); PG8_BAR; PG8_MMA(0, 0, At, B0); PG8_MMA(0, 1, At, B1); PG8_BAR; PG8_SCHED;
            PG8_LDA(At, 1, 1); PG8_STAGE(PG8_SB(1, 0), b3, voffB); PG8_STAGE(PG8_SB(1, 1), b3 + hstep, voffB); PG8_STAGE(PG8_SA(1, 0), a3, o0);
            PG8_WAIT_V(8); PG8_WAIT_L(0); PG8_BAR; PG8_MMA(1, 0, At, B0); PG8_MMA(1, 1, At, B1); PG8_BAR; PG8_SCHED;
        }
        if (wr == 0) PG8_BAR;
        p.epi(acc, cur, wr, wc, fr, fq);
        if (!has_next) break;
#pragma unroll
        for (int a = 0; a < 2; ++a)
#pragma unroll
            for (int b = 0; b < 2; ++b)
#pragma unroll
                for (int m = 0; m < 4; ++m)
#pragma unroll
                    for (int n = 0; n < 2; ++n) acc[a][b][m][n] = (f32x4){0.f, 0.f, 0.f, 0.f};
        cur = nxt; cA = nA; cB = nB; ++ui;
        if constexpr (P::GATHER) { vA[0][0] = vN[0][0]; vA[0][1] = vN[0][1]; vA[1][0] = vN[1][0]; vA[1][1] = vN[1][1]; }
        if (wr == 1) PG8_BAR;
    }
    PG8_WAIT_V(0);
    PG8_BAR;
#undef PG8_SA
#undef PG8_SB
#undef PG8_STAGE
#undef PG8_LDA
#undef PG8_LDB
#undef PG8_MMA
#undef PG8_WAIT_V
#undef PG8_WAIT_L
#undef PG8_BAR
#undef PG8_SCHED
}
}
using pg8::Unit;

constexpr int NWAVES = 8;
struct Frame {
    LAS unsigned char* lds;
    volatile LAS unsigned* MISC;
    gu32* ctl;
    int tid, lane, wave;
    int G, bid;
    unsigned char* ws;
};
struct Args { const float* in[23]; float* out; unsigned char* ws; int ph_lo, ph_hi; };

template <class RowMap>
__device__ __forceinline__ void p0_transpose_item(const float* W, int K, int N, bf16* WT, int ldt, int k_off, LAS float* scr, int item, int lane, const RowMap& rm) {
    const int nblk = N / 32, kb = item / nblk, nb = item % nblk, k0 = 64 * kb, n0 = 32 * nb;
#pragma unroll 8
    for (int i = 0; i < 32; ++i) { const int kk = 2 * i + (lane >> 5); scr[kk * 33 + (lane & 31)] = W[(size_t)(k0 + kk) * N + n0 + (lane & 31)]; }
    LDS_WAIT(); asm volatile("" ::: "memory");
    const int c = lane & 7;
#pragma unroll
    for (int j = 0; j < 4; ++j) { const int n = (lane >> 3) + 8 * j; const LAS float* s = scr + (8 * c) * 33 + n;
        v4u o; o.x = cvt_pk_bf16(s[0 * 33], s[1 * 33]); o.y = cvt_pk_bf16(s[2 * 33], s[3 * 33]); o.z = cvt_pk_bf16(s[4 * 33], s[5 * 33]); o.w = cvt_pk_bf16(s[6 * 33], s[7 * 33]);
        *(GAS v4u*)(WT + (size_t)rm(n0 + n) * ldt + k_off + k0 + 8 * c) = o; }
    LDS_WAIT(); asm volatile("" ::: "memory");
}
struct RmId { __device__ __forceinline__ int operator()(int n) const { return n; } };
struct RmUp { __device__ __forceinline__ int operator()(int n) const { const int j = n >> 1, s = n & 1; return 256 * (j >> 7) + 128 * s + (j & 127); } };
__device__ __forceinline__ void rms_row_to_bf16(const float* xrow, const float* gain, bf16* orow, int lane) {
    const GAS f32x4* xr = (const GAS f32x4*)xrow + lane; const GAS f32x4* gr = (const GAS f32x4*)gain + lane;
    f32x4 v[4]; float s = 0.f;
#pragma unroll
    for (int j = 0; j < 4; ++j) { v[j] = xr[64 * j]; s += (v[j].x * v[j].x + v[j].y * v[j].y) + (v[j].z * v[j].z + v[j].w * v[j].w); }
    const float rstd = 1.f / sqrtf(wave_sum(s) * (1.f / D) + EPS);
    GAS v2u* o8 = (GAS v2u*)orow + lane;
#pragma unroll
    for (int j = 0; j < 4; ++j) { const f32x4 g = gr[64 * j]; v2u o; o.x = cvt_pk_bf16(v[j].x * rstd * g.x, v[j].y * rstd * g.y); o.y = cvt_pk_bf16(v[j].z * rstd * g.z, v[j].w * rstd * g.w); o8[64 * j] = o; }
}
__device__ __forceinline__ void p0_prologue(Frame& F, const Args& a) {
    LAS float* scr = (LAS float*)(F.lds + F.wave * 16384);
    const int gw = F.bid * NWAVES + F.wave, NGW = F.G * NWAVES;
    bf16* Win_t = (bf16*)(F.ws + WS_WIN); bf16* Wmkv_t = (bf16*)(F.ws + WS_WMKV); bf16* Wbr_t = (bf16*)(F.ws + WS_WBR); bf16* Wout_t = (bf16*)(F.ws + WS_WOUT);
    bf16* Wup_t = (bf16*)(F.ws + WS_WUP); bf16* Wdn_t = (bf16*)(F.ws + WS_WDN);
    constexpr int I_IN = (D / 64) * (INW / 32), I_MKV = 16 * 32, I_BS = 8 * 32, I_BR = 16 * 32, I_BM = 8 * 32, I_OUT = 16 * 32, I_UP1 = 16 * 64, I_DN1 = 16 * 32;
    constexpr int I_UP = NE * I_UP1, I_DN = NE * I_DN1;
    constexpr int NITEMS = I_IN + I_MKV + I_BS + I_BR + I_BM + I_OUT + I_UP + I_DN;
    for (int it = gw; it < NITEMS; it += NGW) {
        int r = it;
        if (r < I_IN) { p0_transpose_item(a.in[4], D, INW, Win_t, D, 0, scr, r, F.lane, RmId()); continue; } r -= I_IN;
        if (r < I_MKV) { p0_transpose_item(a.in[9], D, 1024, Wmkv_t, D, 0, scr, r, F.lane, RmId()); continue; } r -= I_MKV;
        if (r < I_BS) { p0_transpose_item(a.in[12], 512, D, Wbr_t, 2048, 0, scr, r, F.lane, RmId()); continue; } r -= I_BS;
        if (r < I_BR) { p0_transpose_item(a.in[13], 1024, D, Wbr_t, 2048, 512, scr, r, F.lane, RmId()); continue; } r -= I_BR;
        if (r < I_BM) { p0_transpose_item(a.in[14], 512, D, Wbr_t, 2048, 1536, scr, r, F.lane, RmId()); continue; } r -= I_BM;
        if (r < I_OUT) { p0_transpose_item(a.in[15], D, D, Wout_t, D, 0, scr, r, F.lane, RmId()); continue; } r -= I_OUT;
        if (r < I_UP) { const int e = r / I_UP1; p0_transpose_item(a.in[19] + (size_t)e * D * 2048, D, 2048, Wup_t + (size_t)e * 2048 * D, D, 0, scr, r % I_UP1, F.lane, RmUp()); continue; } r -= I_UP;
        { const int e = r / I_DN1; p0_transpose_item(a.in[21] + (size_t)e * DFF * D, DFF, D, Wdn_t + (size_t)e * D * DFF, DFF, 0, scr, r % I_DN1, F.lane, RmId()); }
    }
    bf16* H = (bf16*)(F.ws + WS_H); bf16* MB = (bf16*)(F.ws + WS_MB);
    for (int m = gw; m < T; m += NGW) rms_row_to_bf16(a.in[0] + (size_t)m * D, a.in[2], H + (size_t)m * D, F.lane);
    for (int m = gw; m < TM; m += NGW) rms_row_to_bf16(a.in[1] + (size_t)m * D, a.in[3], MB + (size_t)m * D, F.lane);
    float* rc = (float*)(F.ws + WS_ROPE); float* rs = rc + SEQ * 64;
    for (int i = F.bid * 512 + F.tid; i < SEQ * 64; i += F.G * 512) { const int s = i >> 6, j = i & 63;
        const double inv = exp2(-(double)j * (13.287712379549449 / 64.0));
        const double rev = (double)s * inv * 0.15915494309189535; const float fr = (float)(rev - floor(rev));
        rc[i] = __builtin_amdgcn_cosf(fr); rs[i] = __builtin_amdgcn_sinf(fr); }
    float* wrt = (float*)(F.ws + WS_WR);
    for (int i = F.bid * 512 + F.tid; i < NE * D; i += F.G * 512) { const int e = i >> 10, k = i & 1023; wrt[i] = a.in[17][(size_t)k * NE + e]; }
}

__device__ __forceinline__ void epi_store_bf16(const f32x4 (&acc)[2][2][4][2], bf16* base, int ldc, int wr, int wc, int fr, int fq) {
    bf16* b0 = base + (size_t)(wr * 64 + fr) * ldc + wc * 32 + 8 * fq;
#pragma unroll
    for (int ai = 0; ai < 2; ++ai)
#pragma unroll
        for (int m = 0; m < 4; ++m) { bf16* rowp = b0 + (size_t)(ai * 128 + m * 16) * ldc;
#pragma unroll
            for (int bj = 0; bj < 2; ++bj) { const f32x4 v0 = acc[ai][bj][m][0], v1 = acc[ai][bj][m][1];
                v4u w; w.x = cvt_pk_bf16(v0[0], v0[1]); w.y = cvt_pk_bf16(v0[2], v0[3]); w.z = cvt_pk_bf16(v1[0], v1[1]); w.w = cvt_pk_bf16(v1[2], v1[3]);
                *(v4u*)(rowp + bj * 128) = w; } }
}
struct P1Policy {
    static constexpr bool PERM = true, GATHER = false, HAS_MID = false;
    int K, G, c; const bf16 *H, *MB, *Win, *Wmkv; bf16 *Z, *MKV;
    static constexpr int NM1 = T / 256, NN1 = INW / 256, NU1 = NM1 * NN1, NU2 = (TM / 256) * 4;
    __device__ __forceinline__ bool next(int i, Unit& u) const {
        const int L = i * G + c;
        if (L < NU1) { u.e = 0; return pg8::static_order(L, NM1, NN1, u.pm, u.pn); }
        const int L2 = L - NU1; if (L2 >= NU2) return false;
        u.e = 1; u.pm = L2 >> 2; u.pn = L2 & 3; return true;
    }
    __device__ __forceinline__ const char* a_base(const Unit& u) const { return (const char*)(u.e ? MB : H) + (size_t)u.pm * 256 * D * 2; }
    __device__ __forceinline__ const char* b_base(const Unit& u) const { return (const char*)(u.e ? Wmkv : Win) + (size_t)u.pn * 256 * D * 2; }
    __device__ __forceinline__ void a_off(const Unit&, int, unsigned (&)[2][2]) const {}
    __device__ __forceinline__ void mid(f32x4 (&)[2][2][4][2], const Unit&, int, int, int, int, int) const {}
    __device__ __forceinline__ void epi(const f32x4 (&acc)[2][2][4][2], const Unit& u, int wr, int wc, int fr, int fq) const {
        if (u.e) epi_store_bf16(acc, MKV + (size_t)u.pm * 256 * 1024 + u.pn * 256, 1024, wr, wc, fr, fq);
        else epi_store_bf16(acc, Z + (size_t)u.pm * 256 * INW + u.pn * 256, INW, wr, wc, fr, fq);
    }
};


__device__ __forceinline__ int crow(int r, int hi) { return (r & 3) + 8 * (r >> 2) + 4 * hi; }
#define MFMA32(a, b, c) __builtin_amdgcn_mfma_f32_32x32x16_bf16((a), (b), (c), 0, 0, 0)
__device__ __forceinline__ float ret_log2g(int h) { return h == 0 ? -0.04580368961312479f : (h == 1 ? -0.02272007650008353f : (h == 2 ? -0.011315313227834146f : -0.005646563141142062f)); }
__device__ __forceinline__ void unpack8(const v4u w, float (&f)[8]) { f[0] = bf_lo(w.x); f[1] = bf_hi(w.x); f[2] = bf_lo(w.y); f[3] = bf_hi(w.y); f[4] = bf_lo(w.z); f[5] = bf_hi(w.z); f[6] = bf_lo(w.w); f[7] = bf_hi(w.w); }
__device__ __forceinline__ v4u pack8(const float (&f)[8]) { v4u w; w.x = cvt_pk_bf16(f[0], f[1]); w.y = cvt_pk_bf16(f[2], f[3]); w.z = cvt_pk_bf16(f[4], f[5]); w.w = cvt_pk_bf16(f[6], f[7]); return w; }
__device__ __forceinline__ bf16x8 as_bf16x8(v4u w) { return __builtin_bit_cast(bf16x8, w); }
__device__ __forceinline__ void st16(LAS unsigned char* p, unsigned short v) { *(LAS unsigned short*)p = v; }

__device__ __forceinline__ void rot16(const v4u la, const v4u lb, const v4u ha, const v4u hb, const float* cs, const float* sn, float scale, float (&o1)[16], float (&o2)[16]) {
    float t1[16], t2[16];
    { float f[8]; unpack8(la, f);
#pragma unroll
      for (int e = 0; e < 8; ++e) t1[e] = f[e]; unpack8(lb, f);
#pragma unroll
      for (int e = 0; e < 8; ++e) t1[8 + e] = f[e]; unpack8(ha, f);
#pragma unroll
      for (int e = 0; e < 8; ++e) t2[e] = f[e]; unpack8(hb, f);
#pragma unroll
      for (int e = 0; e < 8; ++e) t2[8 + e] = f[e]; }
#pragma unroll
    for (int q = 0; q < 4; ++q) { const f32x4 c4 = *(const GAS f32x4*)(cs + 4 * q), s4 = *(const GAS f32x4*)(sn + 4 * q);
#pragma unroll
        for (int e = 0; e < 4; ++e) { const float a = t1[4 * q + e], b = t2[4 * q + e]; o1[4 * q + e] = (a * c4[e] - b * s4[e]) * scale; o2[4 * q + e] = (a * s4[e] + b * c4[e]) * scale; } }
}

__device__ __forceinline__ void ret_scan_unit(Frame& F, int unit) {
    const int b = unit >> 4, h = (unit >> 2) & 3, dq = unit & 3;
    const bf16* Z = (const bf16*)(F.ws + WS_Z);
    const float* rc = (const float*)(F.ws + WS_ROPE); const float* rs = rc + SEQ * 64;
    bf16* ST = (bf16*)(F.ws + WS_ST) + (size_t)((b * 4 + h) * 16) * 256 * 128;
    const float l2g = ret_log2g(h), cd = exp2f(128.f * l2g);
    const int m = F.tid >> 2, cg = F.tid & 3;
    const int dvt = F.wave >> 2, dkt = F.wave & 3, r = F.lane & 31, hh = F.lane >> 5;
    LAS unsigned char* Kt = F.lds; LAS unsigned char* Vt = F.lds + 34816;
    f32x16 acc;
#pragma unroll
    for (int i = 0; i < 16; ++i) acc[i] = 0.f;
    const float kd = 0.08838834764831845f * exp2f((float)(127 - m) * l2g);
    for (int c = 0; c < 16; ++c) {
        { bf16* dst = ST + (size_t)c * 256 * 128 + (size_t)(dq * 64 + dvt * 32) * 128 + dkt * 32 + r;
#pragma unroll
          for (int i = 0; i < 16; ++i) dst[crow(i, hh) * 128] = (bf16)(cvt_pk_bf16(acc[i], 0.f) & 0xffffu); }
        if (c == 15) break;
        const size_t row = (size_t)(b * SEQ + c * 128 + m);
        const bf16* kp = Z + row * INW + C_RK + h * 128 + cg * 16;
        const v4u k1a = *(const GAS v4u*)kp, k1b = *(const GAS v4u*)(kp + 8), k2a = *(const GAS v4u*)(kp + 64), k2b = *(const GAS v4u*)(kp + 72);
        const bf16* vp = Z + row * INW + C_RV + h * 256 + dq * 64 + cg * 16;
        const v4u va = *(const GAS v4u*)vp, vb = *(const GAS v4u*)(vp + 8);
        float o1[16], o2[16];
        rot16(k1a, k1b, k2a, k2b, rc + (size_t)(c * 128 + m) * 64 + cg * 16, rs + (size_t)(c * 128 + m) * 64 + cg * 16, kd, o1, o2);
        __syncthreads();
#pragma unroll
        for (int e = 0; e < 16; e += 2) { const unsigned w1 = cvt_pk_bf16(o1[e], o1[e + 1]), w2 = cvt_pk_bf16(o2[e], o2[e + 1]);
            st16(Kt + (cg * 16 + e) * 272 + m * 2, (unsigned short)w1); st16(Kt + (cg * 16 + e + 1) * 272 + m * 2, (unsigned short)(w1 >> 16));
            st16(Kt + (64 + cg * 16 + e) * 272 + m * 2, (unsigned short)w2); st16(Kt + (64 + cg * 16 + e + 1) * 272 + m * 2, (unsigned short)(w2 >> 16)); }
        { const unsigned vw[8] = {va.x, va.y, va.z, va.w, vb.x, vb.y, vb.z, vb.w};
#pragma unroll
          for (int e = 0; e < 8; ++e) { st16(Vt + (cg * 16 + 2 * e) * 272 + m * 2, (unsigned short)vw[e]); st16(Vt + (cg * 16 + 2 * e + 1) * 272 + m * 2, (unsigned short)(vw[e] >> 16)); } }
        __syncthreads();
#pragma unroll
        for (int i = 0; i < 16; ++i) acc[i] *= cd;
#pragma unroll
        for (int ks = 0; ks < 8; ++ks) { const bf16x8 af = *(const LAS bf16x8*)(Vt + (dvt * 32 + r) * 272 + (ks * 16 + 8 * hh) * 2), bfr = *(const LAS bf16x8*)(Kt + (dkt * 32 + r) * 272 + (ks * 16 + 8 * hh) * 2);
            acc = MFMA32(af, bfr, acc); }
    }
    __syncthreads();
}

__device__ __forceinline__ void swa_unit(Frame& F, const Args& a, int unit) {
    const int b = unit >> 6, hk = (unit >> 5) & 1, qh = unit & 31, p0 = qh * 64;
    const bf16* Z = (const bf16*)(F.ws + WS_Z); bf16* OCb = (bf16*)(F.ws + WS_OC);
    LAS unsigned char* Kl = F.lds; LAS unsigned char* Vt = F.lds + 27648; LAS unsigned char* Ost = F.lds + 53248 + F.wave * 4608;
    const float* qw = a.in[5]; const float* kw = a.in[6];
#pragma unroll
    for (int i = 0; i < 3; ++i) { const int ci = F.tid + 512 * i, row = ci >> 3, ch = ci & 7, kp = p0 - 128 + row;
        v4u kq = (v4u){0u, 0u, 0u, 0u}, vq = (v4u){0u, 0u, 0u, 0u};
        if (kp >= 0) { const bf16* base = Z + (size_t)(b * SEQ + kp) * INW; kq = *(const GAS v4u*)(base + C_SK + hk * 64 + ch * 8); vq = *(const GAS v4u*)(base + C_SV + hk * 64 + ch * 8); }
        float f[8]; unpack8(kq, f); float ss = 0.f;
#pragma unroll
        for (int e = 0; e < 8; ++e) ss += f[e] * f[e];
        ss += __shfl_xor(ss, 1); ss += __shfl_xor(ss, 2); ss += __shfl_xor(ss, 4);
        const float rstd = 1.f / sqrtf(ss * (1.f / 64.f) + EPS);
        const f32x4 w0 = *(const GAS f32x4*)(kw + ch * 8), w1 = *(const GAS f32x4*)(kw + ch * 8 + 4);
#pragma unroll
        for (int e = 0; e < 4; ++e) { f[e] *= rstd * w0[e]; f[4 + e] *= rstd * w1[e]; }
        *(LAS v4u*)(Kl + row * 144 + ch * 16) = pack8(f);
        const unsigned vw[4] = {vq.x, vq.y, vq.z, vq.w};
#pragma unroll
        for (int e = 0; e < 4; ++e) { st16(Vt + (ch * 8 + 2 * e) * 400 + row * 2, (unsigned short)vw[e]); st16(Vt + (ch * 8 + 2 * e + 1) * 400 + row * 2, (unsigned short)(vw[e] >> 16)); } }
    const int g = F.wave >> 1, half = F.wave & 1, r = F.lane & 31, hh = F.lane >> 5;
    const int hq = hk * 4 + g, qi = 32 * half + r;
    bf16x8 qf[4];
    { const bf16* qb = Z + (size_t)(b * SEQ + p0 + qi) * INW + C_SQ + hq * 64 + 8 * hh;
      v4u raw[4]; float ss = 0.f;
#pragma unroll
      for (int ks = 0; ks < 4; ++ks) { raw[ks] = *(const GAS v4u*)(qb + ks * 16); float f[8]; unpack8(raw[ks], f);
#pragma unroll
          for (int e = 0; e < 8; ++e) ss += f[e] * f[e]; }
      ss += __shfl_xor(ss, 32);
      const float rstd = 0.125f / sqrtf(ss * (1.f / 64.f) + EPS);
#pragma unroll
      for (int ks = 0; ks < 4; ++ks) { float f[8]; unpack8(raw[ks], f); const f32x4 w0 = *(const GAS f32x4*)(qw + ks * 16 + 8 * hh), w1 = *(const GAS f32x4*)(qw + ks * 16 + 8 * hh + 4);
#pragma unroll
          for (int e = 0; e < 4; ++e) { f[e] *= rstd * w0[e]; f[4 + e] *= rstd * w1[e]; }
          qf[ks] = as_bf16x8(pack8(f)); } }
    __syncthreads();
    f32x16 s[6];
#pragma unroll
    for (int kb = 0; kb < 6; ++kb) {
#pragma unroll
        for (int i = 0; i < 16; ++i) s[kb][i] = 0.f;
#pragma unroll
        for (int ks = 0; ks < 4; ++ks) { const bf16x8 af = *(const LAS bf16x8*)(Kl + (32 * kb + r) * 144 + (ks * 16 + 8 * hh) * 2); s[kb] = MFMA32(af, qf[ks], s[kb]); } }
    const float sink = a.in[7][hq];
    float mx = sink;
#pragma unroll
    for (int kb = 0; kb < 6; ++kb)
#pragma unroll
        for (int i = 0; i < 16; ++i) { const int kj = 32 * kb + crow(i, hh); const bool valid = (kj > qi) && (kj <= qi + 128) && (p0 - 128 + kj >= 0);
            s[kb][i] = valid ? s[kb][i] : -1e30f; mx = fmaxf(mx, s[kb][i]); }
    mx = fmaxf(mx, __shfl_xor(mx, 32));
    float l = 0.f;
#pragma unroll
    for (int kb = 0; kb < 6; ++kb)
#pragma unroll
        for (int i = 0; i < 16; ++i) { const float pv = __expf(s[kb][i] - mx); s[kb][i] = pv; l += pv; }
    l += __shfl_xor(l, 32); l += __expf(sink - mx);
    f32x16 o[2];
#pragma unroll
    for (int dt = 0; dt < 2; ++dt)
#pragma unroll
        for (int i = 0; i < 16; ++i) o[dt][i] = 0.f;
#pragma unroll
    for (int kb = 0; kb < 6; ++kb)
#pragma unroll
        for (int s2 = 0; s2 < 2; ++s2) { v4u pw; pw.x = cvt_pk_bf16(s[kb][8 * s2 + 0], s[kb][8 * s2 + 1]); pw.y = cvt_pk_bf16(s[kb][8 * s2 + 2], s[kb][8 * s2 + 3]); pw.z = cvt_pk_bf16(s[kb][8 * s2 + 4], s[kb][8 * s2 + 5]); pw.w = cvt_pk_bf16(s[kb][8 * s2 + 6], s[kb][8 * s2 + 7]);
            const bf16x8 pf = as_bf16x8(pw);
#pragma unroll
            for (int dt = 0; dt < 2; ++dt) { const v2u lo = *(const LAS v2u*)(Vt + (32 * dt + r) * 400 + (32 * kb + 16 * s2 + 4 * hh) * 2), hi = *(const LAS v2u*)(Vt + (32 * dt + r) * 400 + (32 * kb + 16 * s2 + 8 + 4 * hh) * 2);
                o[dt] = MFMA32(as_bf16x8((v4u){lo.x, lo.y, hi.x, hi.y}), pf, o[dt]); } }
    const float inv = 1.f / l;
#pragma unroll
    for (int dt = 0; dt < 2; ++dt)
#pragma unroll
        for (int gq = 0; gq < 4; ++gq) { v2u w; w.x = cvt_pk_bf16(o[dt][4 * gq] * inv, o[dt][4 * gq + 1] * inv); w.y = cvt_pk_bf16(o[dt][4 * gq + 2] * inv, o[dt][4 * gq + 3] * inv);
            *(LAS v2u*)(Ost + r * 144 + (32 * dt + 8 * gq + 4 * hh) * 2) = w; }
    LDS_WAIT(); __builtin_amdgcn_wave_barrier();
#pragma unroll
    for (int i = 0; i < 4; ++i) { const int q = F.lane + 64 * i, row = q >> 3, ch = q & 7; const v4u v = *(const LAS v4u*)(Ost + row * 144 + ch * 16);
        *(GAS v4u*)(OCb + (size_t)(b * SEQ + p0 + 32 * half + row) * OC + hq * 64 + ch * 8) = v; }
    __syncthreads();
}

namespace ma {
constexpr int KVBLK = 64, LDQ = INW, LDK = 1024, LDO = OC;
constexpr float SCALE = 0.088388347648318440f, THR = 8.f;
constexpr int SHM_V = KVBLK * 128 * 2, SHM_K = KVBLK * 128 * 2;
#define MA_KSWZ(row, colB) ((row) * 256 + ((colB) ^ (((row) & 7) << 4)))
#define MA_SBAR() __builtin_amdgcn_sched_barrier(0)
__device__ __forceinline__ void partialSM(f32x16& p0, f32x16& p1, float& m_reg, float& mn, float& alpha) {
    constexpr float C = SCALE * 1.4426950408889634f;
    float pmax = p0[0];
#pragma unroll
    for (int r = 1; r < 16; ++r) pmax = fmaxf(pmax, p0[r]);
#pragma unroll
    for (int r = 0; r < 16; ++r) pmax = fmaxf(pmax, p1[r]);
    pmax = fmaxf(pmax, __shfl_xor(pmax, 32));
    if (__builtin_expect(__all(pmax - m_reg <= THR / SCALE), 1)) { mn = m_reg; alpha = 1.f; }
    else { mn = fmaxf(m_reg, pmax); alpha = __builtin_amdgcn_exp2f((m_reg - mn) * C); m_reg = mn; }
    const float mnC = -mn * C;
#pragma unroll
    for (int r = 0; r < 16; ++r) p0[r] = fmaf(p0[r], C, mnC);
#pragma unroll
    for (int r = 0; r < 16; ++r) p1[r] = fmaf(p1[r], C, mnC);
#pragma unroll
    for (int r = 0; r < 16; ++r) p0[r] = __builtin_amdgcn_exp2f(p0[r]);
}
__device__ __forceinline__ void finishSM(f32x16& p0, f32x16& p1, float alpha, float& l_reg, bf16x8& pa0, bf16x8& pa1, bf16x8& pa2, bf16x8& pa3) {
#pragma unroll
    for (int r = 0; r < 16; ++r) p1[r] = __builtin_amdgcn_exp2f(p1[r]);
    float ps = 0;
#pragma unroll
    for (int r = 0; r < 16; ++r) ps += p0[r];
#pragma unroll
    for (int r = 0; r < 16; ++r) ps += p1[r];
    ps += __shfl_xor(ps, 32);
    l_reg = l_reg * alpha + ps;
#define MA_PK4(P, BASE, OUT) do { unsigned a0 = cvt_pk_bf16(P[BASE + 0], P[BASE + 1]), a1 = cvt_pk_bf16(P[BASE + 2], P[BASE + 3]);   \
    unsigned b0 = cvt_pk_bf16(P[BASE + 4], P[BASE + 5]), b1 = cvt_pk_bf16(P[BASE + 6], P[BASE + 7]);                              \
    auto r0 = __builtin_amdgcn_permlane32_swap(a0, b0, false, false); auto r1 = __builtin_amdgcn_permlane32_swap(a1, b1, false, false); \
    v4u w = {r0[0], r1[0], r0[1], r1[1]}; OUT = as_bf16x8(w); } while (0)
    MA_PK4(p0, 0, pa0); MA_PK4(p0, 8, pa1); MA_PK4(p1, 0, pa2); MA_PK4(p1, 8, pa3);
#undef MA_PK4
}
__device__ __forceinline__ void qkt(f32x16& p0, f32x16& p1, const LAS unsigned char* Ks, const bf16x8* qr, int r32, int hi) {
#pragma unroll
    for (int r = 0; r < 16; ++r) { p0[r] = 0.f; p1[r] = 0.f; }
#pragma unroll
    for (int d0 = 0; d0 < 8; ++d0) { const int cb = (d0 * 16 + hi * 8) * 2;
        const bf16x8 b0 = *(const LAS bf16x8*)(Ks + MA_KSWZ(r32, cb));
        const bf16x8 b1 = *(const LAS bf16x8*)(Ks + MA_KSWZ(32 + r32, cb));
        p0 = MFMA32(b0, qr[d0], p0);
        p1 = MFMA32(b1, qr[d0], p1); }
}
__device__ __forceinline__ int v_st(int k, int c) { const int kk = (k & ~0xC) | ((k & 4) << 1) | ((k & 8) >> 1); return ((kk >> 3) * 4 + (c >> 5)) * 512 + ((kk & 7) * 32 + (c & 31)) * 2; }
__device__ __forceinline__ int v_rd_base(int lane) { return ((lane & 3) << 3) | (((lane >> 2) & 3) << 6) | (((lane >> 4) & 1) << 5) | (((lane >> 5) & 1) << 8); }
constexpr int v_rd_off(int d0, int ks, int half) { return d0 * 512 + ks * 4096 + half * 2048; }
template <int OFF> __device__ __forceinline__ s16x4 tr_read(int vb) {
    s16x4 r; asm volatile("ds_read_b64_tr_b16 %0, %1 offset:%2" : "=&v"(r) : "v"(vb), "i"(OFF) : "memory"); return r;
}
template <int D0> __device__ __forceinline__ void pv_one(f32x16& od, int vb, bf16x8 pa0, bf16x8 pa1, bf16x8 pa2, bf16x8 pa3) {
    const s16x4 l0 = tr_read<v_rd_off(D0, 0, 0)>(vb), h0 = tr_read<v_rd_off(D0, 0, 1)>(vb), l1 = tr_read<v_rd_off(D0, 1, 0)>(vb), h1 = tr_read<v_rd_off(D0, 1, 1)>(vb);
    const s16x4 l2 = tr_read<v_rd_off(D0, 2, 0)>(vb), h2 = tr_read<v_rd_off(D0, 2, 1)>(vb), l3 = tr_read<v_rd_off(D0, 3, 0)>(vb), h3 = tr_read<v_rd_off(D0, 3, 1)>(vb);
    asm volatile("s_waitcnt lgkmcnt(0)" ::: "memory"); MA_SBAR();
#define MA_PK(L, H) (bf16x8){L[0], L[1], L[2], L[3], H[0], H[1], H[2], H[3]}
    od = MFMA32(pa0, MA_PK(l0, h0), od);
    od = MFMA32(pa1, MA_PK(l1, h1), od);
    od = MFMA32(pa2, MA_PK(l2, h2), od);
    od = MFMA32(pa3, MA_PK(l3, h3), od);
#undef MA_PK
}
__device__ __forceinline__ void pv_d0(f32x16* o, int vb, bf16x8 pa0, bf16x8 pa1, bf16x8 pa2, bf16x8 pa3) {
    pv_one<0>(o[0], vb, pa0, pa1, pa2, pa3); pv_one<1>(o[1], vb, pa0, pa1, pa2, pa3); pv_one<2>(o[2], vb, pa0, pa1, pa2, pa3); pv_one<3>(o[3], vb, pa0, pa1, pa2, pa3);
}
__device__ __forceinline__ void body(const bf16* __restrict__ Qb, const bf16* __restrict__ Kh, const bf16* __restrict__ Vh, bf16* __restrict__ Ob, const float* qw, const float* kw, LAS unsigned char* lds) {
    const int tid = threadIdx.x, wid = tid >> 6, lane = tid & 63, r32 = lane & 31, hi = lane >> 5;
    LAS unsigned char* V_lds = lds; LAS unsigned char* K_lds = lds + 2 * SHM_V;
    LAS float* wsl = (LAS float*)(lds + 2 * SHM_V + 2 * SHM_K) + wid * 64; LAS float* li_l = wsl; LAS float* al_l = wsl + 32;
    float m_reg = -1e30f, l_reg = 0; f32x16 o[4]; bf16x8 qr[8];
#pragma unroll
    for (int d = 0; d < 4; ++d)
#pragma unroll
        for (int r = 0; r < 16; ++r) o[d][r] = 0.f;
    { const bf16* Qw = Qb + (size_t)(wid * 32 + r32) * LDQ + hi * 8; v4u raw[8]; float ss = 0.f;
#pragma unroll
      for (int d0 = 0; d0 < 8; ++d0) { raw[d0] = *(const GAS v4u*)(Qw + d0 * 16); float f[8]; unpack8(raw[d0], f);
#pragma unroll
          for (int e = 0; e < 8; ++e) ss += f[e] * f[e]; }
      ss += __shfl_xor(ss, 32);
      const float rstd = 1.f / sqrtf(ss * (1.f / 128.f) + EPS);
#pragma unroll
      for (int d0 = 0; d0 < 8; ++d0) { float f[8]; unpack8(raw[d0], f); const f32x4 w0 = *(const GAS f32x4*)(qw + d0 * 16 + hi * 8), w1 = *(const GAS f32x4*)(qw + d0 * 16 + hi * 8 + 4);
#pragma unroll
          for (int e = 0; e < 4; ++e) { f[e] *= rstd * w0[e]; f[4 + e] *= rstd * w1[e]; }
          qr[d0] = as_bf16x8(pack8(f)); } }
    const int sr = tid >> 4, sc = (tid & 15) * 8, vst0 = v_st(sr, sc), vst1 = v_st(32 + sr, sc);
    const int vb0 = (int)(uintptr_t)V_lds + v_rd_base(lane);
    const f32x4 kw0 = *(const GAS f32x4*)(kw + sc), kw1 = *(const GAS f32x4*)(kw + sc + 4);
    v4u s_vs0[2], s_vs1[2], s_ks0[2], s_ks1[2];
#define MA_SLOAD(i, k0) do { s_vs0[i] = *(const GAS v4u*)(&Vh[(size_t)((k0) + sr) * LDK + sc]); s_vs1[i] = *(const GAS v4u*)(&Vh[(size_t)((k0) + 32 + sr) * LDK + sc]); \
    s_ks0[i] = *(const GAS v4u*)(&Kh[(size_t)((k0) + sr) * LDK + sc]); s_ks1[i] = *(const GAS v4u*)(&Kh[(size_t)((k0) + 32 + sr) * LDK + sc]); } while (0)
#define MA_KNORM(x) ({ float f_[8]; unpack8((x), f_); float ss_ = 0.f; _Pragma("unroll") for (int e_ = 0; e_ < 8; ++e_) ss_ += f_[e_] * f_[e_]; \
    ss_ += __shfl_xor(ss_, 1); ss_ += __shfl_xor(ss_, 2); ss_ += __shfl_xor(ss_, 4); ss_ += __shfl_xor(ss_, 8); const float rs_ = 1.f / sqrtf(ss_ * (1.f / 128.f) + EPS); \
    _Pragma("unroll") for (int e_ = 0; e_ < 4; ++e_) { f_[e_] *= rs_ * kw0[e_]; f_[4 + e_] *= rs_ * kw1[e_]; } pack8(f_); })
#define MA_SWRITE(b, i) do { *(LAS v4u*)(V_lds + (b) * SHM_V + vst0) = s_vs0[i];          \
    *(LAS v4u*)(V_lds + (b) * SHM_V + vst1) = s_vs1[i]; const int kc = sc * 2;               \
    *(LAS v4u*)(K_lds + (b) * SHM_K + MA_KSWZ(sr, kc)) = MA_KNORM(s_ks0[i]);                       \
    *(LAS v4u*)(K_lds + (b) * SHM_K + MA_KSWZ(32 + sr, kc)) = MA_KNORM(s_ks1[i]); } while (0)
#define MA_SWAIT() asm volatile("s_waitcnt vmcnt(4)" ::: "memory")
#define MA_RESC(a) do { if (__any((a) < 1.f)) { if (hi == 0) al_l[r32] = (a); asm volatile("s_waitcnt lgkmcnt(0)" ::: "memory"); \
    _Pragma("unroll") for (int d = 0; d < 4; ++d) _Pragma("unroll") for (int r = 0; r < 16; ++r) o[d][r] *= al_l[crow(r, hi)]; } } while (0)
    f32x16 pA0, pA1, pB0, pB1; float mnA, mnB, alA, alB; bf16x8 pa0, pa1, pa2, pa3; constexpr int NT = MEMLEN / KVBLK;
    MA_SLOAD(0, 0); asm volatile("s_waitcnt vmcnt(0)" ::: "memory"); MA_SWRITE(0, 0); __syncthreads();
    qkt(pA0, pA1, K_lds, qr, r32, hi); partialSM(pA0, pA1, m_reg, mnA, alA);
    MA_SLOAD(1, KVBLK); MA_SLOAD(0, 2 * KVBLK);
    MA_SWAIT(); MA_SWRITE(1, 1); __syncthreads();
#pragma unroll 1
    for (int j = 1; j + 1 < NT; j += 2) {
        MA_SBAR(); qkt(pB0, pB1, K_lds + SHM_K, qr, r32, hi);
        finishSM(pA0, pA1, alA, l_reg, pa0, pa1, pa2, pa3); MA_SBAR();
        MA_SLOAD(1, (j + 2) * KVBLK); MA_SBAR();
        pv_d0(o, vb0, pa0, pa1, pa2, pa3); partialSM(pB0, pB1, m_reg, mnB, alB);
        __syncthreads(); MA_SWAIT(); MA_SWRITE(0, 0);
        MA_RESC(alB); __syncthreads();
        MA_SBAR(); qkt(pA0, pA1, K_lds, qr, r32, hi);
        finishSM(pB0, pB1, alB, l_reg, pa0, pa1, pa2, pa3); MA_SBAR();
        if (j + 3 < NT) MA_SLOAD(0, (j + 3) * KVBLK);
        MA_SBAR();
        pv_d0(o, vb0 + SHM_V, pa0, pa1, pa2, pa3); partialSM(pA0, pA1, m_reg, mnA, alA);
        __syncthreads(); asm volatile("s_waitcnt vmcnt(0)" ::: "memory"); MA_SWRITE(1, 1);
        MA_RESC(alA); __syncthreads();
    }
    MA_SBAR(); qkt(pB0, pB1, K_lds + SHM_K, qr, r32, hi);
    finishSM(pA0, pA1, alA, l_reg, pa0, pa1, pa2, pa3); MA_SBAR();
    pv_d0(o, vb0, pa0, pa1, pa2, pa3); partialSM(pB0, pB1, m_reg, mnB, alB);
    __syncthreads(); MA_RESC(alB);
    finishSM(pB0, pB1, alB, l_reg, pa0, pa1, pa2, pa3); MA_SBAR();
    pv_d0(o, vb0 + SHM_V, pa0, pa1, pa2, pa3);
    if (hi == 0) li_l[r32] = l_reg; asm volatile("s_waitcnt lgkmcnt(0)" ::: "memory");
    float rli[16];
#pragma unroll
    for (int r = 0; r < 16; ++r) rli[r] = __builtin_amdgcn_rcpf(li_l[crow(r, hi)]);
    bf16* Ow = Ob + (size_t)(wid * 32) * LDO;
#pragma unroll
    for (int r = 0; r < 16; ++r) { const int orow = crow(r, hi);
#pragma unroll
        for (int d0 = 0; d0 < 4; ++d0) Ow[(size_t)orow * LDO + d0 * 32 + r32] = (bf16)(cvt_pk_bf16(o[d0][r] * rli[r], 0.f) & 0xffffu); }
    __syncthreads();
#undef MA_SLOAD
#undef MA_SWRITE
#undef MA_SWAIT
#undef MA_RESC
#undef MA_KNORM
}
}

__device__ __forceinline__ void ret_out_unit(Frame& F, const Args& a, int unit) {
    const int b = unit >> 6, h = (unit >> 4) & 3, c = unit & 15;
    const bf16* Z = (const bf16*)(F.ws + WS_Z); bf16* OCb = (bf16*)(F.ws + WS_OC);
    const float* rc = (const float*)(F.ws + WS_ROPE); const float* rs = rc + SEQ * 64;
    const bf16* ST = (const bf16*)(F.ws + WS_ST) + (size_t)((b * 4 + h) * 16 + c) * 256 * 128;
    const float l2g = ret_log2g(h);
    LAS unsigned char* Ql = F.lds; LAS unsigned char* Kl = F.lds + 34816; LAS unsigned char* Vt = F.lds + 69632; LAS f32x2* stats = (LAS f32x2*)(F.lds + 139264); LAS unsigned char* Ost = F.lds;
    { const int m = F.tid >> 2, cg = F.tid & 3; const size_t row = (size_t)(b * SEQ + c * 128 + m);
      const float* cs = rc + (size_t)(c * 128 + m) * 64 + cg * 16; const float* sn = rs + (size_t)(c * 128 + m) * 64 + cg * 16;
      { const bf16* qp = Z + row * INW + C_RQ + h * 128 + cg * 16; float o1[16], o2[16];
        rot16(*(const GAS v4u*)qp, *(const GAS v4u*)(qp + 8), *(const GAS v4u*)(qp + 64), *(const GAS v4u*)(qp + 72), cs, sn, 1.f, o1, o2);
        float t[8];
#pragma unroll
        for (int q = 0; q < 2; ++q) {
#pragma unroll
            for (int e = 0; e < 8; ++e) t[e] = o1[8 * q + e];
            *(LAS v4u*)(Ql + m * 272 + (cg * 16 + 8 * q) * 2) = pack8(t);
#pragma unroll
            for (int e = 0; e < 8; ++e) t[e] = o2[8 * q + e];
            *(LAS v4u*)(Ql + m * 272 + (64 + cg * 16 + 8 * q) * 2) = pack8(t); } }
      { const bf16* kp = Z + row * INW + C_RK + h * 128 + cg * 16; float o1[16], o2[16];
        rot16(*(const GAS v4u*)kp, *(const GAS v4u*)(kp + 8), *(const GAS v4u*)(kp + 64), *(const GAS v4u*)(kp + 72), cs, sn, 0.08838834764831845f, o1, o2);
        float t[8];
#pragma unroll
        for (int q = 0; q < 2; ++q) {
#pragma unroll
            for (int e = 0; e < 8; ++e) t[e] = o1[8 * q + e];
            *(LAS v4u*)(Kl + m * 272 + (cg * 16 + 8 * q) * 2) = pack8(t);
#pragma unroll
            for (int e = 0; e < 8; ++e) t[e] = o2[8 * q + e];
            *(LAS v4u*)(Kl + m * 272 + (64 + cg * 16 + 8 * q) * 2) = pack8(t); } }
      const bf16* vp = Z + row * INW + C_RV + h * 256 + cg * 64;
#pragma unroll
      for (int q = 0; q < 8; ++q) { const v4u vv = *(const GAS v4u*)(vp + 8 * q); const unsigned vw[4] = {vv.x, vv.y, vv.z, vv.w};
#pragma unroll
          for (int e = 0; e < 4; ++e) { st16(Vt + (cg * 64 + 8 * q + 2 * e) * 272 + m * 2, (unsigned short)vw[e]); st16(Vt + (cg * 64 + 8 * q + 2 * e + 1) * 272 + m * 2, (unsigned short)(vw[e] >> 16)); } } }
    __syncthreads();
    const int lb = F.wave & 3, dh = F.wave >> 2, r = F.lane & 31, hh = F.lane >> 5, l = 32 * lb + r;
    bf16x8 qb[8];
#pragma unroll
    for (int ks = 0; ks < 8; ++ks) qb[ks] = *(const LAS bf16x8*)(Ql + l * 272 + (ks * 16 + 8 * hh) * 2);
    f32x16 o[4];
#pragma unroll
    for (int dt = 0; dt < 4; ++dt)
#pragma unroll
        for (int i = 0; i < 16; ++i) o[dt][i] = 0.f;
    if (c > 0) {
#pragma unroll
        for (int dt = 0; dt < 4; ++dt) { const bf16* sp = ST + (size_t)(dh * 128 + 32 * dt + r) * 128 + 8 * hh;
#pragma unroll
            for (int ks = 0; ks < 8; ++ks) { const bf16x8 af = as_bf16x8(*(const GAS v4u*)(sp + ks * 16)); o[dt] = MFMA32(af, qb[ks], o[dt]); } }
        const float qd = exp2f((float)(l + 1) * l2g);
#pragma unroll
        for (int dt = 0; dt < 4; ++dt)
#pragma unroll
            for (int i = 0; i < 16; ++i) o[dt][i] *= qd;
    }
#pragma unroll 1
    for (int mb = 0; mb <= lb; ++mb) {
        f32x16 s;
#pragma unroll
        for (int i = 0; i < 16; ++i) s[i] = 0.f;
#pragma unroll
        for (int ks = 0; ks < 8; ++ks) { const bf16x8 af = *(const LAS bf16x8*)(Kl + (32 * mb + r) * 272 + (ks * 16 + 8 * hh) * 2); s = MFMA32(af, qb[ks], s); }
#pragma unroll
        for (int i = 0; i < 16; ++i) { const int m = 32 * mb + crow(i, hh); s[i] = (l >= m) ? s[i] * exp2f((float)(l - m) * l2g) : 0.f; }
#pragma unroll
        for (int s2 = 0; s2 < 2; ++s2) { v4u pw; pw.x = cvt_pk_bf16(s[8 * s2 + 0], s[8 * s2 + 1]); pw.y = cvt_pk_bf16(s[8 * s2 + 2], s[8 * s2 + 3]); pw.z = cvt_pk_bf16(s[8 * s2 + 4], s[8 * s2 + 5]); pw.w = cvt_pk_bf16(s[8 * s2 + 6], s[8 * s2 + 7]);
            const bf16x8 pf = as_bf16x8(pw);
#pragma unroll
            for (int dt = 0; dt < 4; ++dt) { const LAS unsigned char* vr = Vt + (dh * 128 + 32 * dt + r) * 272 + (32 * mb + 16 * s2 + 4 * hh) * 2;
                const v2u lo = *(const LAS v2u*)vr, hi = *(const LAS v2u*)(vr + 16);
                o[dt] = MFMA32(as_bf16x8((v4u){lo.x, lo.y, hi.x, hi.y}), pf, o[dt]); } }
    }
    float sm = 0.f, sq = 0.f;
#pragma unroll
    for (int dt = 0; dt < 4; ++dt)
#pragma unroll
        for (int i = 0; i < 16; ++i) { sm += o[dt][i]; sq += o[dt][i] * o[dt][i]; }
    sm += __shfl_xor(sm, 32); sq += __shfl_xor(sq, 32);
    if (hh == 0) stats[dh * 128 + l] = (f32x2){sm, sq};
    __syncthreads();
    { const f32x2 s0 = stats[l], s1 = stats[128 + l]; const float mean = (s0.x + s1.x) * (1.f / 256.f); const float var = fmaxf((s0.y + s1.y) * (1.f / 256.f) - mean * mean, 0.f);
      const float rstd = 1.f / sqrtf(var + EPS); const float* nw = a.in[8] + h * 256 + dh * 128;
#pragma unroll
      for (int dt = 0; dt < 4; ++dt)
#pragma unroll
          for (int gq = 0; gq < 4; ++gq) { const int dvl = 32 * dt + 8 * gq + 4 * hh; const f32x4 w4 = *(const GAS f32x4*)(nw + dvl);
              v2u w; w.x = cvt_pk_bf16((o[dt][4 * gq] - mean) * rstd * w4[0], (o[dt][4 * gq + 1] - mean) * rstd * w4[1]); w.y = cvt_pk_bf16((o[dt][4 * gq + 2] - mean) * rstd * w4[2], (o[dt][4 * gq + 3] - mean) * rstd * w4[3]);
              *(LAS v2u*)(Ost + l * 528 + (dh * 128 + dvl) * 2) = w; } }
    __syncthreads();
#pragma unroll
    for (int i = 0; i < 8; ++i) { const int id = F.tid + 512 * i, row = id >> 5, ch = id & 31; const size_t grow = (size_t)(b * SEQ + c * 128 + row);
        const v4u ov = *(const LAS v4u*)(Ost + row * 528 + ch * 16); const v4u gv = *(const GAS v4u*)(Z + grow * INW + C_RG + h * 256 + ch * 8);
        float fo[8], fg[8]; unpack8(ov, fo); unpack8(gv, fg);
#pragma unroll
        for (int e = 0; e < 8; ++e) fo[e] *= fg[e] * sigmoidf_(fg[e]);
        *(GAS v4u*)(OCb + grow * OC + 512 + h * 256 + ch * 8) = pack8(fo); }
    __syncthreads();
}


struct P4Policy {
    static constexpr bool PERM = true, GATHER = false, HAS_MID = true;
    int K, G, c; const bf16 *OCb, *Wbr, *Z; bf16* MG;
    __device__ __forceinline__ bool next(int i, Unit& u) const { u.e = 0; return pg8::static_order(i * G + c, T / 256, 4, u.pm, u.pn); }
    __device__ __forceinline__ const char* a_base(const Unit& u) const { return (const char*)OCb + (size_t)u.pm * 256 * OC * 2; }
    __device__ __forceinline__ const char* b_base(const Unit& u) const { return (const char*)Wbr + (size_t)u.pn * 256 * OC * 2; }
    __device__ __forceinline__ void a_off(const Unit&, int, unsigned (&)[2][2]) const {}
    __device__ __forceinline__ void mid(f32x4 (&acc)[2][2][4][2], const Unit& u, int t, int wr, int wc, int fr, int fq) const {
        if (t != 8 && t != 24) return;
        const int br = (t == 8) ? 0 : 1;
        const bf16* zb = Z + (size_t)(u.pm * 256 + wr * 64 + fr) * INW + C_ZG + br * 1024 + u.pn * 256 + wc * 32 + 8 * fq;
#pragma unroll
        for (int ai = 0; ai < 2; ++ai)
#pragma unroll
            for (int m = 0; m < 4; ++m) { const bf16* zr = zb + (size_t)(ai * 128 + m * 16) * INW;
#pragma unroll
                for (int bj = 0; bj < 2; ++bj) { const v4u ga = *(const GAS v4u*)(zr + bj * 128), gb = *(const GAS v4u*)(zr + 1024 + bj * 128);
                    float fa[8], fb[8]; unpack8(ga, fa); unpack8(gb, fb); float rt[8];
#pragma unroll
                    for (int e = 0; e < 8; ++e) rt[e] = (1.f + __expf(-fb[e])) / (1.f + __expf(-fa[e]));
                    acc[ai][bj][m][0] *= (f32x4){rt[0], rt[1], rt[2], rt[3]}; acc[ai][bj][m][1] *= (f32x4){rt[4], rt[5], rt[6], rt[7]}; }
                asm volatile("" ::: "memory"); }
    }
    __device__ __forceinline__ void epi(f32x4 (&acc)[2][2][4][2], const Unit& u, int wr, int wc, int fr, int fq) const {
        const bf16* zb = Z + (size_t)(u.pm * 256 + wr * 64 + fr) * INW + C_ZG + 2 * 1024 + u.pn * 256 + wc * 32 + 8 * fq;
        bf16* ob = MG + (size_t)(u.pm * 256 + wr * 64 + fr) * D + u.pn * 256 + wc * 32 + 8 * fq;
#pragma unroll
        for (int ai = 0; ai < 2; ++ai)
#pragma unroll
            for (int m = 0; m < 4; ++m) {
#pragma unroll
                for (int bj = 0; bj < 2; ++bj) { const v4u ga = *(const GAS v4u*)(zb + (size_t)(ai * 128 + m * 16) * INW + bj * 128); float fa[8]; unpack8(ga, fa); float r[8];
#pragma unroll
                    for (int e = 0; e < 4; ++e) { r[e] = acc[ai][bj][m][0][e] * sigmoidf_(fa[e]); r[4 + e] = acc[ai][bj][m][1][e] * sigmoidf_(fa[4 + e]); }
                    *(GAS v4u*)(ob + (size_t)(ai * 128 + m * 16) * D + bj * 128) = pack8(r); }
                asm volatile("" ::: "memory"); }
    }
};
struct P5Policy {
    static constexpr bool PERM = false, GATHER = false, HAS_MID = false;
    int K, G, c; const bf16 *MG, *Wout; const float* X; float* OUT;
    __device__ __forceinline__ bool next(int i, Unit& u) const { u.e = 0; return pg8::static_order(i * G + c, T / 256, 4, u.pm, u.pn); }
    __device__ __forceinline__ const char* a_base(const Unit& u) const { return (const char*)MG + (size_t)u.pm * 256 * D * 2; }
    __device__ __forceinline__ const char* b_base(const Unit& u) const { return (const char*)Wout + (size_t)u.pn * 256 * D * 2; }
    __device__ __forceinline__ void a_off(const Unit&, int, unsigned (&)[2][2]) const {}
    __device__ __forceinline__ void mid(f32x4 (&)[2][2][4][2], const Unit&, int, int, int, int, int) const {}
    __device__ __forceinline__ void epi(f32x4 (&acc)[2][2][4][2], const Unit& u, int wr, int wc, int fr, int fq) const {
        const size_t off0 = (size_t)(u.pm * 256 + wr * 64 + fr) * D + u.pn * 256 + wc * 32 + 4 * fq;
#pragma unroll
        for (int ai = 0; ai < 2; ++ai)
#pragma unroll
            for (int m = 0; m < 4; ++m) { const size_t off = off0 + (size_t)(ai * 128 + m * 16) * D;
#pragma unroll
                for (int bj = 0; bj < 2; ++bj)
#pragma unroll
                    for (int n = 0; n < 2; ++n) { const f32x4 xv = *(const GAS f32x4*)(X + off + bj * 128 + n * 16); *(GAS f32x4*)(OUT + off + bj * 128 + n * 16) = xv + acc[ai][bj][m][n]; }
                asm volatile("" ::: "memory"); }
    }
};
__device__ __forceinline__ void p6_router(Frame& F, const Args& a) {
    LAS float* WrT = (LAS float*)F.lds;
    LAS int* sel_e = (LAS int*)(F.lds + 131072); LAS float* sel_g = (LAS float*)(F.lds + 131072 + 2048); LAS int* sel_p = (LAS int*)(F.lds + 131072 + 4096);
    LAS int* lcnt = (LAS int*)(F.lds + 131072 + 6144); LAS int* lbase = (LAS int*)(F.lds + 131072 + 6144 + 128);
    { const float* wrt = (const float*)(F.ws + WS_WR);
#pragma unroll 4
      for (int i = 0; i < 16; ++i) { const int o = (F.tid + 512 * i) * 4; *(LAS f32x4*)(WrT + o) = *(const GAS f32x4*)(wrt + o); } }
    const float* gain = a.in[16]; const float* brt = a.in[18];
    bf16* H2 = (bf16*)(F.ws + WS_H); int* list = (int*)(F.ws + WS_LIST); float* gate_tk = (float*)(F.ws + WS_GATE);
    unsigned* gcnt = (unsigned*)(F.ctl + CW_CNT);
    const int lane = F.lane;
    f32x4 gn[4];
#pragma unroll
    for (int j = 0; j < 4; ++j) gn[j] = *(const GAS f32x4*)(gain + 4 * lane + 256 * j);
    const float mybias = brt[lane & 31];
    for (int chunk = F.bid; chunk < T / 128; chunk += F.G) {
        if (F.tid < 32) lcnt[F.tid] = 0;
        __syncthreads();
#pragma unroll 1
        for (int grp = 0; grp < 4; ++grp) {
            const int rl0 = F.wave * 16 + grp * 4; const int row0 = chunk * 128 + rl0;
            f32x4 hv[4][4];
#pragma unroll
            for (int rr = 0; rr < 4; ++rr) { const GAS f32x4* xr = (const GAS f32x4*)(a.out + (size_t)(row0 + rr) * D) + lane; float ss = 0.f;
#pragma unroll
                for (int j = 0; j < 4; ++j) { hv[rr][j] = xr[64 * j]; ss += (hv[rr][j].x * hv[rr][j].x + hv[rr][j].y * hv[rr][j].y) + (hv[rr][j].z * hv[rr][j].z + hv[rr][j].w * hv[rr][j].w); }
                const float rstd = 1.f / sqrtf(wave_sum(ss) * (1.f / D) + EPS);
                GAS v2u* o8 = (GAS v2u*)(H2 + (size_t)(row0 + rr) * D) + lane;
#pragma unroll
                for (int j = 0; j < 4; ++j) { hv[rr][j] = hv[rr][j] * rstd * gn[j]; v2u o; o.x = cvt_pk_bf16(hv[rr][j].x, hv[rr][j].y); o.y = cvt_pk_bf16(hv[rr][j].z, hv[rr][j].w); o8[64 * j] = o; } }
            float lg[4] = {0.f, 0.f, 0.f, 0.f};
#pragma unroll 1
            for (int e = 0; e < NE; ++e) { f32x4 w4[4];
#pragma unroll
                for (int j = 0; j < 4; ++j) w4[j] = *(const LAS f32x4*)(WrT + e * 1024 + 4 * lane + 256 * j);
#pragma unroll
                for (int rr = 0; rr < 4; ++rr) { float p = 0.f;
#pragma unroll
                    for (int j = 0; j < 4; ++j) p += (hv[rr][j].x * w4[j].x + hv[rr][j].y * w4[j].y) + (hv[rr][j].z * w4[j].z + hv[rr][j].w * w4[j].w);
                    p = wave_sum(p); lg[rr] = ((lane & 31) == e) ? p : lg[rr]; } }
#pragma unroll
            for (int rr = 0; rr < 4; ++rr) {
                float val = (lane < 32) ? lg[rr] + mybias : -3.0e38f; float tv[4]; int ti[4];
#pragma unroll
                for (int k = 0; k < 4; ++k) { float mv = val; int mi = lane;
#pragma unroll
                    for (int o = 1; o < 64; o <<= 1) { const float ov = __shfl_xor(mv, o); const int oi = __shfl_xor(mi, o); const bool take = (ov > mv) || (ov == mv && oi < mi); mv = take ? ov : mv; mi = take ? oi : mi; }
                    tv[k] = mv; ti[k] = mi; val = (lane == mi) ? -3.0e38f : val; }
                const float e1 = __expf(tv[1] - tv[0]), e2 = __expf(tv[2] - tv[0]), e3 = __expf(tv[3] - tv[0]); const float inv = 1.f / (1.f + e1 + e2 + e3);
                if (lane < 4) { const int ek = lane == 0 ? ti[0] : (lane == 1 ? ti[1] : (lane == 2 ? ti[2] : ti[3])); const float gk = (lane == 0 ? 1.f : (lane == 1 ? e1 : (lane == 2 ? e2 : e3))) * inv;
                    const int pos = atomicAdd((int*)(lcnt + ek), 1); const int sl = (rl0 + rr) * 4 + lane; sel_e[sl] = ek; sel_g[sl] = gk; sel_p[sl] = pos; } }
        }
        __syncthreads();
        if (F.tid < 32) lbase[F.tid] = (int)__hip_atomic_fetch_add(gcnt + F.tid, (unsigned)lcnt[F.tid], RLX_AGENT);
        __syncthreads();
        { const int e = sel_e[F.tid], pos = lbase[e] + sel_p[F.tid]; const int dest = (chunk * 128 + (F.tid >> 2)) * 4 + (F.tid & 3);
          list[(size_t)e * LCAP + pos] = dest; gate_tk[dest] = sel_g[F.tid]; }
        __syncthreads();
    }
}
__device__ __forceinline__ void moe_table(Frame& F) {
    if (F.tid < 32) F.MISC[64 + F.tid] = __hip_atomic_load(F.ctl + CW_CNT + F.tid, RLX_AGENT);
    __syncthreads();
    if (F.tid == 0) { unsigned s = 0; for (int e = 0; e < NE; ++e) { F.MISC[16 + e] = s; s += (F.MISC[64 + e] + 255u) >> 8; } F.MISC[16 + NE] = s; }
    __syncthreads();
}
template <int NPN>
__device__ __forceinline__ bool moe_next(volatile LAS unsigned* MISC, int L, Unit& u) {
    const int total = (int)MISC[16 + NE] * NPN; if (L >= total) return false;
    const int tile = L / NPN; u.pn = L % NPN; int e = 0;
#pragma unroll 1
    for (int k = 1; k < NE; ++k) e = ((int)MISC[16 + k] <= tile) ? k : e;
    u.e = e; u.pm = tile; u.x = tile - (int)MISC[16 + e]; return true;
}
struct P7Policy {
    static constexpr bool PERM = true, GATHER = true, HAS_MID = false;
    int K, G, c; const bf16 *H2, *Wup; bf16* ACT; const int* list; const float* bup; volatile LAS unsigned* MISC;
    __device__ __forceinline__ bool next(int i, Unit& u) const { return moe_next<8>(MISC, i * G + c, u); }
    __device__ __forceinline__ const char* a_base(const Unit&) const { return (const char*)H2; }
    __device__ __forceinline__ const char* b_base(const Unit& u) const { return (const char*)Wup + ((size_t)u.e * 2048 + (size_t)u.pn * 256) * D * 2; }
    __device__ __forceinline__ void a_off(const Unit& u, int tid, unsigned (&v)[2][2]) const {
        const int cnt = (int)MISC[64 + u.e];
#pragma unroll
        for (int i = 0; i < 2; ++i) { int R, C; pg8::stage_rc(tid * 16 + i * 8192, R, C);
#pragma unroll
            for (int h = 0; h < 2; ++h) { const int idx = u.x * 256 + h * 128 + R; const int tok = (idx < cnt) ? (list[(size_t)u.e * LCAP + idx] >> 2) : 0; v[h][i] = (unsigned)tok * (unsigned)(D * 2) + (unsigned)(C * 2); } }
    }
    __device__ __forceinline__ void mid(f32x4 (&)[2][2][4][2], const Unit&, int, int, int, int, int) const {}
    __device__ __forceinline__ void epi(f32x4 (&acc)[2][2][4][2], const Unit& u, int wr, int wc, int fr, int fq) const {
        const int oc0 = u.pn * 128 + wc * 32 + 8 * fq;
        const float* bp = bup + (size_t)u.e * 2048 + 2 * oc0;
        f32x4 bb[4];
#pragma unroll
        for (int q = 0; q < 4; ++q) bb[q] = *(const GAS f32x4*)(bp + 4 * q);
        bf16* ob = ACT + (size_t)(u.pm * 256 + wr * 64 + fr) * DFF + oc0;
#pragma unroll
        for (int ai = 0; ai < 2; ++ai)
#pragma unroll
            for (int m = 0; m < 4; ++m) { float r[8];
#pragma unroll
                for (int n = 0; n < 2; ++n)
#pragma unroll
                    for (int q = 0; q < 4; ++q) { const int j = 4 * n + q;
                        const float bg = bb[(2 * j) >> 2][(2 * j) & 3], bl = bb[(2 * j + 1) >> 2][(2 * j + 1) & 3];
                        const float xg = fminf(acc[ai][0][m][n][q] + bg, 7.f), xl = fminf(fmaxf(acc[ai][1][m][n][q] + bl, -7.f), 7.f);
                        r[j] = xg * sigmoidf_(1.702f * xg) * (xl + 1.f); }
                *(GAS v4u*)(ob + (size_t)(ai * 128 + m * 16) * DFF) = pack8(r); }
    }
};
struct P8Policy {
    static constexpr bool PERM = true, GATHER = false, HAS_MID = false;
    int K, G, c; const bf16 *ACT, *Wdn; bf16* Y; const int* list; const float* gate_tk; const float* bdn; volatile LAS unsigned* MISC;
    __device__ __forceinline__ bool next(int i, Unit& u) const { return moe_next<4>(MISC, i * G + c, u); }
    __device__ __forceinline__ const char* a_base(const Unit& u) const { return (const char*)ACT + (size_t)u.pm * 256 * DFF * 2; }
    __device__ __forceinline__ const char* b_base(const Unit& u) const { return (const char*)Wdn + ((size_t)u.e * 1024 + (size_t)u.pn * 256) * DFF * 2; }
    __device__ __forceinline__ void a_off(const Unit&, int, unsigned (&)[2][2]) const {}
    __device__ __forceinline__ void mid(f32x4 (&)[2][2][4][2], const Unit&, int, int, int, int, int) const {}
    __device__ __forceinline__ void epi(f32x4 (&acc)[2][2][4][2], const Unit& u, int wr, int wc, int fr, int fq) const {
        const int cnt = (int)MISC[64 + u.e]; const int c0 = u.pn * 256 + wc * 32 + 8 * fq;
        f32x4 bb[2][2];
#pragma unroll
        for (int bj = 0; bj < 2; ++bj)
#pragma unroll
            for (int n = 0; n < 2; ++n) bb[bj][n] = *(const GAS f32x4*)(bdn + (size_t)u.e * 1024 + c0 + bj * 128 + 4 * n);
#pragma unroll
        for (int ai = 0; ai < 2; ++ai)
#pragma unroll
            for (int m = 0; m < 4; ++m) { const int idx = u.x * 256 + ai * 128 + wr * 64 + m * 16 + fr;
                if (idx < cnt) { const int dest = list[(size_t)u.e * LCAP + idx]; const float gt = gate_tk[dest]; bf16* yp = Y + (size_t)dest * D + c0;
#pragma unroll
                    for (int bj = 0; bj < 2; ++bj) { float r[8];
#pragma unroll
                        for (int q = 0; q < 4; ++q) { r[q] = (acc[ai][bj][m][0][q] + bb[bj][0][q]) * gt; r[4 + q] = (acc[ai][bj][m][1][q] + bb[bj][1][q]) * gt; }
                        *(GAS v4u*)(yp + bj * 128) = pack8(r); } } }
    }
};
__device__ __forceinline__ void p9_combine(Frame& F, const Args& a) {
    const bf16* Y = (const bf16*)(F.ws + WS_Y);
    const int gw = F.bid * NWAVES + F.wave, NGW = F.G * NWAVES;
    for (int t = gw; t < T; t += NGW) {
        GAS f32x4* xr = (GAS f32x4*)(a.out + (size_t)t * D) + F.lane;
        f32x4 v[4];
#pragma unroll
        for (int j = 0; j < 4; ++j) v[j] = xr[64 * j];
#pragma unroll
        for (int k = 0; k < 4; ++k) { const GAS v2u* yr = (const GAS v2u*)(Y + ((size_t)t * 4 + k) * D) + F.lane;
#pragma unroll
            for (int j = 0; j < 4; ++j) { const v2u w = yr[64 * j]; v[j] += (f32x4){bf_lo(w.x), bf_hi(w.x), bf_lo(w.y), bf_hi(w.y)}; } }
#pragma unroll
        for (int j = 0; j < 4; ++j) xr[64 * j] = v[j];
    }
}

__global__ void __launch_bounds__(NWAVES * 64, 2) fwd(Args args) {
    extern __shared__ __attribute__((aligned(16))) unsigned char lds[];
    Frame F;
    F.lds = (LAS unsigned char*)lds;
    F.MISC = (volatile LAS unsigned*)(F.lds + MISC_OFF);
    F.tid = threadIdx.x; F.lane = F.tid & 63; F.wave = __builtin_amdgcn_readfirstlane(F.tid >> 6);
    F.G = gridDim.x; F.bid = blockIdx.x; F.ws = args.ws;
    F.ctl = (gu32*)(args.ws + WS_CTL);
    for (int u = F.tid; u < 256; u += NWAVES * 64) ((LAS unsigned*)(F.lds + MISC_OFF))[u] = 0u;
    __syncthreads();
    const int lo = args.ph_lo, hi = args.ph_hi;
    const bool multi = (hi - lo) > 1;
    XcdBarrier bar; bar.bar = (unsigned*)(F.ctl + CW_BAR); bar.x = 0; bar.st = nullptr;
    if (multi) bar = xcd_barrier_post((unsigned*)(F.ctl + CW_BAR), F.MISC);
#define IN(k) (lo <= (k) && (k) < hi)
#define SEAM(k) do { if (IN(k) && IN((k) + 1)) xcd_barrier(bar); } while (0)

    if (IN(0)) { p0_prologue(F, args); }
    SEAM(0);
    if (IN(1)) {
        P1Policy p; p.K = D; p.G = F.G; p.c = F.bid; p.H = (const bf16*)(F.ws + WS_H); p.MB = (const bf16*)(F.ws + WS_MB); p.Win = (const bf16*)(F.ws + WS_WIN); p.Wmkv = (const bf16*)(F.ws + WS_WMKV);
        p.Z = (bf16*)(F.ws + WS_Z); p.MKV = (bf16*)(F.ws + WS_MKV);
        pg8::gemm_phase(F.lds, p);
    }
    SEAM(1);
    if (IN(2)) {
        for (int u = F.bid; u < 256; u += F.G) ret_scan_unit(F, u);
        for (int u = F.bid; u < 1024; u += F.G) swa_unit(F, args, u);
        for (int u = F.bid; u < 512; u += F.G) { const int b = u >> 5, h = (u >> 3) & 3, qb = u & 7;
            const bf16* Z = (const bf16*)(F.ws + WS_Z); const bf16* MKV = (const bf16*)(F.ws + WS_MKV); bf16* OCb = (bf16*)(F.ws + WS_OC);
            ma::body(Z + (size_t)(b * SEQ + qb * 256) * INW + C_MQ + h * 128, MKV + (size_t)(b * MEMLEN) * 1024 + h * 128, MKV + (size_t)(b * MEMLEN) * 1024 + 512 + h * 128,
                     OCb + (size_t)(b * SEQ + qb * 256) * OC + 1536 + h * 128, args.in[10], args.in[11], F.lds); }
    }
    SEAM(2);
    if (IN(3)) { for (int u = F.bid; u < 1024; u += F.G) ret_out_unit(F, args, u); }
    SEAM(3);
    if (IN(4)) {
        P4Policy p; p.K = OC; p.G = F.G; p.c = F.bid; p.OCb = (const bf16*)(F.ws + WS_OC); p.Wbr = (const bf16*)(F.ws + WS_WBR); p.Z = (const bf16*)(F.ws + WS_Z); p.MG = (bf16*)(F.ws + WS_H);
        pg8::gemm_phase(F.lds, p);
    }
    SEAM(4);
    if (IN(5)) {
        P5Policy p; p.K = D; p.G = F.G; p.c = F.bid; p.MG = (const bf16*)(F.ws + WS_H); p.Wout = (const bf16*)(F.ws + WS_WOUT); p.X = args.in[0]; p.OUT = args.out;
        pg8::gemm_phase(F.lds, p);
    }
    SEAM(5);
    if (IN(6)) { p6_router(F, args); }
    SEAM(6);
    if (IN(7)) {
        moe_table(F);
        P7Policy p; p.K = D; p.G = F.G; p.c = F.bid; p.H2 = (const bf16*)(F.ws + WS_H); p.Wup = (const bf16*)(F.ws + WS_WUP); p.ACT = (bf16*)(F.ws + WS_ACT); p.list = (const int*)(F.ws + WS_LIST); p.bup = args.in[20]; p.MISC = F.MISC;
        pg8::gemm_phase(F.lds, p);
    }
    SEAM(7);
    if (IN(8)) {
        moe_table(F);
        P8Policy p; p.K = DFF; p.G = F.G; p.c = F.bid; p.ACT = (const bf16*)(F.ws + WS_ACT); p.Wdn = (const bf16*)(F.ws + WS_WDN); p.Y = (bf16*)(F.ws + WS_Y); p.list = (const int*)(F.ws + WS_LIST);
        p.gate_tk = (const float*)(F.ws + WS_GATE); p.bdn = args.in[22]; p.MISC = F.MISC;
        pg8::gemm_phase(F.lds, p);
    }
    SEAM(8);
    if (IN(9)) { p9_combine(F, args); }
#undef IN
#undef SEAM
}

extern "C" void kernel_launch(void* const* d_in, const int* in_sizes, int n_in, void* d_out, int out_size, void* d_ws, size_t ws_size, hipStream_t stream) {
    static int grid = 0;
    if (grid == 0) {
        if (n_in != 23 || out_size != T * D || ws_size < WS_END) { fprintf(stderr, "kernel_launch: unexpected shapes (n_in %d out %d ws %zu)\n", n_in, out_size, ws_size); grid = -1; return; }
        int dev = 0, cus = 0;
        if (hipGetDevice(&dev) != hipSuccess || hipDeviceGetAttribute(&cus, hipDeviceAttributeMultiprocessorCount, dev) != hipSuccess) { grid = -1; return; }
        if (hipFuncSetAttribute((const void*)fwd, hipFuncAttributeMaxDynamicSharedMemorySize, LDS_BYTES) != hipSuccess) { fprintf(stderr, "kernel_launch: hipFuncSetAttribute failed\n"); grid = -1; return; }
        int per_cu = 0;
        if (hipOccupancyMaxActiveBlocksPerMultiprocessor(&per_cu, (const void*)fwd, NWAVES * 64, LDS_BYTES) != hipSuccess || per_cu < 1) fprintf(stderr, "kernel_launch: occupancy query reports %d\n", per_cu);
        (void)hipGetLastError();
        grid = cus;
    }
    if (grid < 0) return;
    (void)hipMemsetAsync((char*)d_ws + WS_CTL, 0, CTL_ZERO_BYTES, stream);
    Args a{};
    for (int i = 0; i < 23; ++i) a.in[i] = (const float*)d_in[i];
    a.out = (float*)d_out; a.ws = (unsigned char*)d_ws; a.ph_lo = 0; a.ph_hi = 10;
    hipLaunchKernelGGL(fwd, dim3(grid), dim3(NWAVES * 64), LDS_BYTES, stream, a);
}
```

```cpp
#include <hip/hip_runtime.h>
#include <cstdio>
#include <cstdint>
#ifndef PROBE_DUP
#define PROBE_DUP -1
#endif

#define GAS __attribute__((address_space(1)))
#define LAS __attribute__((address_space(3)))
typedef unsigned short bf16;
typedef unsigned v4u __attribute__((ext_vector_type(4)));
typedef unsigned v2u __attribute__((ext_vector_type(2)));
typedef float f32x4 __attribute__((ext_vector_type(4)));
typedef float f32x2 __attribute__((ext_vector_type(2)));
typedef float f32x16 __attribute__((ext_vector_type(16)));
typedef short bf16x8 __attribute__((ext_vector_type(8)));
typedef short s16x4 __attribute__((ext_vector_type(4)));
typedef GAS unsigned gu32;
#define RLX_AGENT __ATOMIC_RELAXED, __HIP_MEMORY_SCOPE_AGENT
#define LDS_WAIT() asm volatile("s_waitcnt lgkmcnt(0)" ::: "memory")
#define VM_WAIT() asm volatile("s_waitcnt vmcnt(0)" ::: "memory")

constexpr int D = 1024, BATCH = 16, SEQ = 2048, T = BATCH * SEQ;
constexpr int MEMLEN = 256, TM = BATCH * MEMLEN;
constexpr int INW = 7424;
constexpr int C_SQ = 0, C_SK = 512, C_SV = 640, C_RQ = 768, C_RK = 1280, C_RV = 1792, C_RG = 2816, C_MQ = 3840, C_ZG = 4352;
constexpr int NE = 32, TOPK = 4, DFF = 1024;
constexpr int OC = 2048;
constexpr float EPS = 1e-6f;
constexpr int LCAP = T;
constexpr int ACT_ROWS = T * TOPK + NE * 256;

constexpr size_t MiB = 1u << 20;
constexpr size_t WS_CTL = 0, CTL_ZERO_BYTES = 1 * MiB;
constexpr size_t WS_ROPE = 1 * MiB;
constexpr size_t WS_WIN = 2 * MiB;
constexpr size_t WS_WMKV = 17 * MiB;
constexpr size_t WS_WBR = 19 * MiB;
constexpr size_t WS_WOUT = 23 * MiB;
constexpr size_t WS_WR = 25 * MiB;
constexpr size_t WS_WUP = 26 * MiB;
constexpr size_t WS_WDN = 154 * MiB;
constexpr size_t WS_H = 218 * MiB;
constexpr size_t WS_MB = 282 * MiB;
constexpr size_t WS_MKV = 290 * MiB;
constexpr size_t WS_Z = 298 * MiB;
constexpr size_t WS_OC = 762 * MiB;
constexpr size_t WS_ST = 890 * MiB;
constexpr size_t WS_LIST = 954 * MiB;
constexpr size_t WS_GATE = 958 * MiB;
constexpr size_t WS_ACT = 298 * MiB;
constexpr size_t WS_Y = 570 * MiB;
constexpr size_t WS_END = 960 * MiB;
static_assert(WS_ACT + (size_t)ACT_ROWS * 1024 * 2 <= WS_Y && WS_Y + (size_t)T * 4 * 1024 * 2 <= WS_ST + 64 * MiB, "overlay map");
constexpr int CW_TMO = 0, CW_CODE = 1;
constexpr int CW_CNT = 64;
constexpr int CW_BAR = 4096;

constexpr int SCR_BYTES = 147456;
constexpr int MISC_OFF = SCR_BYTES;
constexpr int LDS_BYTES = SCR_BYTES + 1024;

__device__ __forceinline__ unsigned cvt_pk_bf16(float lo, float hi) { unsigned r; asm volatile("v_cvt_pk_bf16_f32 %0, %1, %2" : "=v"(r) : "v"(lo), "v"(hi)); return r; }
__device__ __forceinline__ float bf_lo(unsigned w) { return __builtin_bit_cast(float, w << 16); }
__device__ __forceinline__ float bf_hi(unsigned w) { return __builtin_bit_cast(float, w & 0xffff0000u); }
__device__ __forceinline__ float wave_sum(float v) {
#pragma unroll
    for (int o = 1; o < 64; o <<= 1) v += __shfl_xor(v, o);
    return v;
}
__device__ __forceinline__ float sigmoidf_(float x) { return 1.f / (1.f + __expf(-x)); }

#define XB_TMO      128
#define XB_XCNT(j)  (256  + 64 * (j))
#define XB_XSUB(j)  (1280 + 64 * (j))
#define XB_XGEN(j)  (2304 + 64 * (j))
#define XB_TOP      3328
#define XB_TOPGEN   3392
#define XCD_BAR_WORDS 3456
#define XB_SPIN_CAP (1u << 18)
__device__ __forceinline__ unsigned xb_ld(unsigned* p)              { return __hip_atomic_load(p, __ATOMIC_RELAXED, __HIP_MEMORY_SCOPE_AGENT); }
__device__ __forceinline__ unsigned xb_add(unsigned* p, unsigned v) { return __hip_atomic_fetch_add(p, v, __ATOMIC_RELAXED, __HIP_MEMORY_SCOPE_AGENT); }
__device__ __forceinline__ unsigned xb_xcc_id() { return (unsigned)__builtin_amdgcn_s_getreg((3 << 11) | 20) & 0xFu; }
#define XB_SPIN(cond, bar) do { unsigned _sp = 0; while (cond) { __builtin_amdgcn_s_sleep(1); \
    if ((++_sp & 255u) == 0u) { if (xb_ld(&(bar)[XB_TMO])) break; if (_sp > XB_SPIN_CAP) { atomicAdd(&(bar)[XB_TMO], 1u); break; } } } } while (0)
struct XcdBarrier { unsigned* bar; unsigned x; volatile LAS unsigned* st; };
__device__ __forceinline__ XcdBarrier xcd_barrier_post(unsigned* bar, volatile LAS unsigned* st) {
    XcdBarrier b; b.bar = bar; b.x = xb_xcc_id(); b.st = st;
    if (threadIdx.x == 0) (void)xb_add(&bar[XB_XCNT(b.x)], 1u);
    return b;
}
__device__ __forceinline__ void xcd_barrier_complete(unsigned* bar, unsigned x, unsigned& nloc, unsigned& nx) {
    const unsigned G = gridDim.x * gridDim.y * gridDim.z;
    unsigned sum, cnt, mine, sp = 0u;
    for (;;) {
        sum = 0u; cnt = 0u; mine = 0u;
#pragma unroll
        for (unsigned j = 0; j < 16; ++j) { const unsigned c = xb_ld(&bar[XB_XCNT(j)]); sum += c; cnt += (c > 0u) ? 1u : 0u; mine = (j == x) ? c : mine; }
        if (sum == G) break;
        __builtin_amdgcn_s_sleep(1);
        if ((++sp & 255u) == 0u) { if (xb_ld(&bar[XB_TMO])) break; if (sp > XB_SPIN_CAP) { atomicAdd(&bar[XB_TMO], 1u); break; } }
    }
    nloc = mine > 0u ? mine : 1u; nx = cnt > 0u ? cnt : 1u;
}
__device__ __forceinline__ void xcd_barrier(const XcdBarrier& b) {
    asm volatile("s_waitcnt vmcnt(0)" ::: "memory");
    __syncthreads();
    if (threadIdx.x == 0) {
        unsigned* bar = b.bar;
        __builtin_amdgcn_s_waitcnt(0);
        unsigned nloc = b.st[0], nx = b.st[1];
        if (nloc == 0u) { xcd_barrier_complete(bar, b.x, nloc, nx); b.st[0] = nloc; b.st[1] = nx; }
        const unsigned old = xb_add(&bar[XB_XSUB(b.x)], 1u);
        const unsigned gen = old / nloc;
        if (old + 1u == (gen + 1u) * nloc) {
            __builtin_amdgcn_fence(__ATOMIC_RELEASE, "agent");
            asm volatile("s_waitcnt vmcnt(0)" ::: "memory");
            const unsigned og = xb_add(&bar[XB_TOP], 1u);
            const unsigned tg = og / nx;
            if (og + 1u == (tg + 1u) * nx) xb_add(&bar[XB_TOPGEN], 1u);
            else XB_SPIN(xb_ld(&bar[XB_TOPGEN]) == tg, bar);
            __builtin_amdgcn_fence(__ATOMIC_ACQUIRE, "agent");
            xb_add(&bar[XB_XGEN(b.x)], 1u);
            asm volatile("s_waitcnt vmcnt(0)" ::: "memory");
        } else {
            XB_SPIN(xb_ld(&bar[XB_XGEN(b.x)]) == gen, bar);
            __builtin_amdgcn_fence(__ATOMIC_ACQUIRE, "agent");
            asm volatile("s_waitcnt vmcnt(0)" ::: "memory");
        }
    }
    __syncthreads();
}

namespace pg8 {
constexpr int BM = 256, BK = 64, HALF = 128, HTB = HALF * BK * 2, STAGE_BYTES = 8 * HTB, NXCD = 8, WGM = 8;
__device__ __forceinline__ int lds_byte(int r, int c) { const int st = (r >> 4) * 2 + (c >> 5), rr = r & 15, cc = c & 31, ob = rr * 64 + cc * 2; return st * 1024 + (ob ^ (((ob >> 9) & 1) << 5)); }
__device__ __forceinline__ void stage_rc(int b, int& R, int& C) { const int st = b / 1024, sb = b % 1024, swz = sb ^ (((sb >> 9) & 1) << 5); R = (st >> 1) * 16 + swz / 64; C = (st & 1) * 32 + (swz % 64) / 2; }
__device__ __forceinline__ int perm32(int rho) { const int n = rho >> 4, i = rho & 15; return 8 * (i >> 2) + 4 * n + (i & 3); }
struct Unit { int pm, pn, e, x; };
__device__ __forceinline__ bool static_order(int L, int nM, int nN, int& pm, int& pn) {
    const int nwg = nM * nN; if (L >= nwg) return false;
    int wgid = L; { const int q = nwg / NXCD, r = nwg % NXCD, xcd = wgid % NXCD, off = wgid / NXCD; wgid = (xcd < r ? xcd * (q + 1) : r * (q + 1) + (xcd - r) * q) + off; }
    const int nig = WGM * nN, gid = wgid / nig, fm = gid * WGM, gsz = (nM - fm) < WGM ? (nM - fm) : WGM;
    pm = fm + ((wgid % nig) % gsz); pn = (wgid % nig) / gsz; return true;
}
template <class P>
__device__ __forceinline__ void gemm_phase(LAS unsigned char* lds, const P& p) {
    const int tid = threadIdx.x, wid = __builtin_amdgcn_readfirstlane(tid >> 6), lane = tid & 63, wr = wid >> 2, wc = wid & 3, fr = lane & 15, fq = lane >> 4;
    const int K = p.K, nt = K / BK;
    unsigned voffB[2], vA[2][2], vN[2][2];
    const size_t kstep = (size_t)(BK * 2);
    const size_t hstep = (size_t)HALF * K * 2;
#pragma unroll
    for (int i = 0; i < 2; ++i) { int R, C; stage_rc(tid * 16 + i * 8192, R, C); const int Rb = P::PERM ? ((R & ~31) + perm32(R & 31)) : R;
        voffB[i] = (unsigned)(Rb * K + C) * 2u; vA[0][i] = (unsigned)(R * K + C) * 2u; vA[1][i] = vA[0][i] + (unsigned)hstep; }
    const unsigned ldsw = (unsigned)wid * 1024u;
    const int aoff = lds_byte(wr * 64 + fr, fq * 8), boff = lds_byte(wc * 32 + fr, fq * 8);
#define PG8_SA(b, h) (((b) * 2 + (h)) * HTB)
#define PG8_SB(b, h) ((4 + (b) * 2 + (h)) * HTB)
#define PG8_STAGE(bufoff, gbase, voff) do { _Pragma("unroll") for (int _i = 0; _i < 2; ++_i) \
        __builtin_amdgcn_global_load_lds((const unsigned*)((const char*)(gbase) + (voff)[_i]), (LAS unsigned*)(lds + (bufoff) + ldsw + _i * 8192), 16, 0, 0); } while (0)
#define PG8_LDA(dst, b, h) do { _Pragma("unroll") for (int m = 0; m < 4; ++m) _Pragma("unroll") for (int k = 0; k < 2; ++k) dst[m][k] = *(const LAS bf16x8*)(lds + PG8_SA(b, h) + aoff + m * 2048 + k * 1024); } while (0)
#define PG8_LDB(dst, b, h) do { _Pragma("unroll") for (int n = 0; n < 2; ++n) _Pragma("unroll") for (int k = 0; k < 2; ++k) dst[n][k] = *(const LAS bf16x8*)(lds + PG8_SB(b, h) + boff + n * 2048 + k * 1024); } while (0)
#define PG8_MMA(ai, bj, At, Bt) do { __builtin_amdgcn_s_setprio(1); _Pragma("unroll") for (int m = 0; m < 4; ++m) _Pragma("unroll") for (int n = 0; n < 2; ++n) _Pragma("unroll") for (int k = 0; k < 2; ++k) \
        acc[ai][bj][m][n] = __builtin_amdgcn_mfma_f32_16x16x32_bf16(Bt[n][k], At[m][k], acc[ai][bj][m][n], 0, 0, 0); __builtin_amdgcn_s_setprio(0); } while (0)
#define PG8_WAIT_V(n) asm volatile("s_waitcnt vmcnt(" #n ")" ::: "memory")
#define PG8_WAIT_L(n) asm volatile("s_waitcnt lgkmcnt(" #n ")" ::: "memory")
#define PG8_BAR __builtin_amdgcn_s_barrier()
#define PG8_SCHED __builtin_amdgcn_sched_barrier(0)
    Unit cur, nxt; int ui = 0;
    if (!p.next(0, cur)) return;
    f32x4 acc[2][2][4][2];
#pragma unroll
    for (int a = 0; a < 2; ++a)
#pragma unroll
        for (int b = 0; b < 2; ++b)
#pragma unroll
            for (int m = 0; m < 4; ++m)
#pragma unroll
                for (int n = 0; n < 2; ++n) acc[a][b][m][n] = (f32x4){0.f, 0.f, 0.f, 0.f};
    bf16x8 At[4][2], B0[2][2], B1[2][2];
    const char* cA = p.a_base(cur); const char* cB = p.b_base(cur);
    if constexpr (P::GATHER) { p.a_off(cur, tid, vA); asm volatile("" : "+v"(vA[0][0]), "+v"(vA[0][1]), "+v"(vA[1][0]), "+v"(vA[1][1])); }
    PG8_STAGE(PG8_SB(0, 0), cB, voffB); PG8_STAGE(PG8_SB(0, 1), cB + hstep, voffB); PG8_STAGE(PG8_SA(0, 0), cA, vA[0]); PG8_STAGE(PG8_SA(0, 1), cA, vA[1]);
    if (wr == 1) PG8_BAR;
    PG8_WAIT_V(2); PG8_BAR;
    PG8_STAGE(PG8_SB(1, 0), cB + kstep, voffB); PG8_STAGE(PG8_SA(1, 0), cA + kstep, vA[0]); PG8_STAGE(PG8_SB(1, 1), cB + hstep + kstep, voffB);
    PG8_WAIT_V(6); PG8_BAR;
    for (;;) {
        const bool has_next = p.next(ui + 1, nxt);
        const char* nA = has_next ? p.a_base(nxt) : cA; const char* nB = has_next ? p.b_base(nxt) : cB;
        if constexpr (P::GATHER) {
            if (has_next) p.a_off(nxt, tid, vN); else { vN[0][0] = vA[0][0]; vN[0][1] = vA[0][1]; vN[1][0] = vA[1][0]; vN[1][1] = vA[1][1]; }
            asm volatile("" : "+v"(vN[0][0]), "+v"(vN[0][1]), "+v"(vN[1][0]), "+v"(vN[1][1]));
        }
        for (int t = 0; t < nt; t += 2) {
            const bool last = (t == nt - 2);
            if constexpr (P::HAS_MID) p.mid(acc, cur, t, wr, wc, fr, fq);
            const char* a1 = cA + (size_t)(t + 1) * kstep;
            const char* a2 = last ? nA : cA + (size_t)(t + 2) * kstep; const char* b2 = last ? nB : cB + (size_t)(t + 2) * kstep;
            const char* a3 = a2 + kstep; const char* b3 = b2 + kstep;
            unsigned o0[2], o1[2];
            if constexpr (P::GATHER) { o0[0] = last ? vN[0][0] : vA[0][0]; o0[1] = last ? vN[0][1] : vA[0][1]; o1[0] = last ? vN[1][0] : vA[1][0]; o1[1] = last ? vN[1][1] : vA[1][1]; }
            else { o0[0] = vA[0][0]; o0[1] = vA[0][1]; o1[0] = vA[1][0]; o1[1] = vA[1][1]; }
            PG8_LDB(B0, 0, 0); PG8_LDB(B1, 0, 1); PG8_SCHED; PG8_LDA(At, 0, 0); PG8_STAGE(PG8_SA(1, 1), a1, vA[1]);
            PG8_WAIT_V(8); PG8_WAIT_L(0); PG8_BAR; PG8_MMA(0, 0, At, B0); PG8_MMA(0, 1, At, B1); PG8_BAR; PG8_SCHED;
            PG8_LDA(At, 0, 1); PG8_STAGE(PG8_SB(0, 0), b2, voffB); PG8_STAGE(PG8_SB(0, 1), b2 + hstep, voffB); PG8_STAGE(PG8_SA(0, 0), a2, o0);
            PG8_WAIT_V(8); PG8_WAIT_L(0); PG8_BAR; PG8_MMA(1, 0, At, B0); PG8_MMA(1, 1, At, B1); PG8_BAR; PG8_SCHED;
            PG8_LDB(B0, 1, 0); PG8_LDB(B1, 1, 1); PG8_SCHED; PG8_LDA(At, 1, 0); PG8_STAGE(PG8_SA(0, 1), a2, o1);
            PG8_WAIT_V(8); PG8_WAIT_L(0); PG8_BAR; PG8_MMA(0, 0, At, B0); PG8_MMA(0, 1, At, B1); PG8_BAR; PG8_SCHED;
            PG8_LDA(At, 1, 1); PG8_STAGE(PG8_SB(1, 0), b3, voffB); PG8_STAGE(PG8_SB(1, 1), b3 + hstep, voffB); PG8_STAGE(PG8_SA(1, 0), a3, o0);
            PG8_WAIT_V(8); PG8_WAIT_L(0); PG8_BAR; PG8_MMA(1, 0, At, B0); PG8_MMA(1, 1, At, B1); PG8_BAR; PG8_SCHED;
        }
        if (wr == 0) PG8_BAR;
        p.epi(acc, cur, wr, wc, fr, fq);
        if (!has_next) break;
#pragma unroll
        for (int a = 0; a < 2; ++a)
#pragma unroll
            for (int b = 0; b < 2; ++b)
#pragma unroll
                for (int m = 0; m < 4; ++m)
#pragma unroll
                    for (int n = 0; n < 2; ++n) acc[a][b][m][n] = (f32x4){0.f, 0.f, 0.f, 0.f};
        cur = nxt; cA = nA; cB = nB; ++ui;
        if constexpr (P::GATHER) { vA[0][0] = vN[0][0]; vA[0][1] = vN[0][1]; vA[1][0] = vN[1][0]; vA[1][1] = vN[1][1]; }
        if (wr == 1) PG8_BAR;
    }
    PG8_WAIT_V(0);
    PG8_BAR;
#undef PG8_SA
#undef PG8_SB
#undef PG8_STAGE
#undef PG8_LDA
#undef PG8_LDB
#undef PG8_MMA
#undef PG8_WAIT_V
#undef PG8_WAIT_L
#undef PG8_BAR
#undef PG8_SCHED
}
}
using pg8::Unit;

constexpr int NWAVES = 8;
struct Frame {
    LAS unsigned char* lds;
    volatile LAS unsigned* MISC;
    gu32* ctl;
    int tid, lane, wave;
    int G, bid;
    unsigned char* ws;
};
struct Args { const float* in[23]; float* out; unsigned char* ws; int ph_lo, ph_hi, li, pad; };

template <class RowMap>
__device__ __forceinline__ void p0_transpose_item(const float* W, int K, int N, bf16* WT, int ldt, int k_off, LAS float* scr, int item, int lane, const RowMap& rm) {
    const int nblk = N / 32, kb = item / nblk, nb = item % nblk, k0 = 64 * kb, n0 = 32 * nb;
#pragma unroll 8
    for (int i = 0; i < 32; ++i) { const int kk = 2 * i + (lane >> 5); scr[kk * 33 + (lane & 31)] = W[(size_t)(k0 + kk) * N + n0 + (lane & 31)]; }
    LDS_WAIT(); asm volatile("" ::: "memory");
    const int c = lane & 7;
#pragma unroll
    for (int j = 0; j < 4; ++j) { const int n = (lane >> 3) + 8 * j; const LAS float* s = scr + (8 * c) * 33 + n;
        v4u o; o.x = cvt_pk_bf16(s[0 * 33], s[1 * 33]); o.y = cvt_pk_bf16(s[2 * 33], s[3 * 33]); o.z = cvt_pk_bf16(s[4 * 33], s[5 * 33]); o.w = cvt_pk_bf16(s[6 * 33], s[7 * 33]);
        *(GAS v4u*)(WT + (size_t)rm(n0 + n) * ldt + k_off + k0 + 8 * c) = o; }
    LDS_WAIT(); asm volatile("" ::: "memory");
}
struct RmId { __device__ __forceinline__ int operator()(int n) const { return n; } };
struct RmUp { __device__ __forceinline__ int operator()(int n) const { const int j = n >> 1, s = n & 1; return 256 * (j >> 7) + 128 * s + (j & 127); } };
__device__ __forceinline__ void rms_row_to_bf16(const float* xrow, const float* gain, bf16* orow, int lane) {
    const GAS f32x4* xr = (const GAS f32x4*)xrow + lane; const GAS f32x4* gr = (const GAS f32x4*)gain + lane;
    f32x4 v[4]; float s = 0.f;
#pragma unroll
    for (int j = 0; j < 4; ++j) { v[j] = xr[64 * j]; s += (v[j].x * v[j].x + v[j].y * v[j].y) + (v[j].z * v[j].z + v[j].w * v[j].w); }
    const float rstd = 1.f / sqrtf(wave_sum(s) * (1.f / D) + EPS);
    GAS v2u* o8 = (GAS v2u*)orow + lane;
#pragma unroll
    for (int j = 0; j < 4; ++j) { const f32x4 g = gr[64 * j]; v2u o; o.x = cvt_pk_bf16(v[j].x * rstd * g.x, v[j].y * rstd * g.y); o.y = cvt_pk_bf16(v[j].z * rstd * g.z, v[j].w * rstd * g.w); o8[64 * j] = o; }
}
__device__ __forceinline__ void p0_prologue(Frame& F, const Args& a) {
    LAS float* scr = (LAS float*)(F.lds + F.wave * 16384);
    const int gw = F.bid * NWAVES + F.wave, NGW = F.G * NWAVES;
    bf16* Win_t = (bf16*)(F.ws + WS_WIN); bf16* Wmkv_t = (bf16*)(F.ws + WS_WMKV); bf16* Wbr_t = (bf16*)(F.ws + WS_WBR); bf16* Wout_t = (bf16*)(F.ws + WS_WOUT);
    bf16* Wup_t = (bf16*)(F.ws + WS_WUP); bf16* Wdn_t = (bf16*)(F.ws + WS_WDN);
    constexpr int I_IN = (D / 64) * (INW / 32), I_MKV = 16 * 32, I_BS = 8 * 32, I_BR = 16 * 32, I_BM = 8 * 32, I_OUT = 16 * 32, I_UP1 = 16 * 64, I_DN1 = 16 * 32;
    constexpr int I_UP = NE * I_UP1, I_DN = NE * I_DN1;
    constexpr int NITEMS = I_IN + I_MKV + I_BS + I_BR + I_BM + I_OUT + I_UP + I_DN;
    for (int it = gw; it < NITEMS; it += NGW) {
        int r = it;
        if (r < I_IN) { p0_transpose_item(a.in[4], D, INW, Win_t, D, 0, scr, r, F.lane, RmId()); continue; } r -= I_IN;
        if (r < I_MKV) { p0_transpose_item(a.in[9], D, 1024, Wmkv_t, D, 0, scr, r, F.lane, RmId()); continue; } r -= I_MKV;
        if (r < I_BS) { p0_transpose_item(a.in[12], 512, D, Wbr_t, 2048, 0, scr, r, F.lane, RmId()); continue; } r -= I_BS;
        if (r < I_BR) { p0_transpose_item(a.in[13], 1024, D, Wbr_t, 2048, 512, scr, r, F.lane, RmId()); continue; } r -= I_BR;
        if (r < I_BM) { p0_transpose_item(a.in[14], 512, D, Wbr_t, 2048, 1536, scr, r, F.lane, RmId()); continue; } r -= I_BM;
        if (r < I_OUT) { p0_transpose_item(a.in[15], D, D, Wout_t, D, 0, scr, r, F.lane, RmId()); continue; } r -= I_OUT;
        if (r < I_UP) { const int e = r / I_UP1; p0_transpose_item(a.in[19] + (size_t)e * D * 2048, D, 2048, Wup_t + (size_t)e * 2048 * D, D, 0, scr, r % I_UP1, F.lane, RmUp()); continue; } r -= I_UP;
        { const int e = r / I_DN1; p0_transpose_item(a.in[21] + (size_t)e * DFF * D, DFF, D, Wdn_t + (size_t)e * D * DFF, DFF, 0, scr, r % I_DN1, F.lane, RmId()); }
    }
    bf16* H = (bf16*)(F.ws + WS_H); bf16* MB = (bf16*)(F.ws + WS_MB);
    for (int m = gw; m < T; m += NGW) rms_row_to_bf16(a.in[0] + (size_t)m * D, a.in[2], H + (size_t)m * D, F.lane);
    for (int m = gw; m < TM; m += NGW) rms_row_to_bf16(a.in[1] + (size_t)m * D, a.in[3], MB + (size_t)m * D, F.lane);
    float* rc = (float*)(F.ws + WS_ROPE); float* rs = rc + SEQ * 64;
    for (int i = F.bid * 512 + F.tid; i < SEQ * 64; i += F.G * 512) { const int s = i >> 6, j = i & 63;
        const double inv = exp2(-(double)j * (13.287712379549449 / 64.0));
        const double rev = (double)s * inv * 0.15915494309189535; const float fr = (float)(rev - floor(rev));
        rc[i] = __builtin_amdgcn_cosf(fr); rs[i] = __builtin_amdgcn_sinf(fr); }
    float* wrt = (float*)(F.ws + WS_WR);
    for (int i = F.bid * 512 + F.tid; i < NE * D; i += F.G * 512) { const int e = i >> 10, k = i & 1023; wrt[i] = a.in[17][(size_t)k * NE + e]; }
}

__device__ __forceinline__ void epi_store_bf16(const f32x4 (&acc)[2][2][4][2], bf16* base, int ldc, int wr, int wc, int fr, int fq) {
    bf16* b0 = base + (size_t)(wr * 64 + fr) * ldc + wc * 32 + 8 * fq;
#pragma unroll
    for (int ai = 0; ai < 2; ++ai)
#pragma unroll
        for (int m = 0; m < 4; ++m) { bf16* rowp = b0 + (size_t)(ai * 128 + m * 16) * ldc;
#pragma unroll
            for (int bj = 0; bj < 2; ++bj) { const f32x4 v0 = acc[ai][bj][m][0], v1 = acc[ai][bj][m][1];
                v4u w; w.x = cvt_pk_bf16(v0[0], v0[1]); w.y = cvt_pk_bf16(v0[2], v0[3]); w.z = cvt_pk_bf16(v1[0], v1[1]); w.w = cvt_pk_bf16(v1[2], v1[3]);
                *(v4u*)(rowp + bj * 128) = w; } }
}
struct P1Policy {
    static constexpr bool PERM = true, GATHER = false, HAS_MID = false;
    int K, G, c; const bf16 *H, *MB, *Win, *Wmkv; bf16 *Z, *MKV;
    static constexpr int NM1 = T / 256, NN1 = INW / 256, NU1 = NM1 * NN1, NU2 = (TM / 256) * 4;
    __device__ __forceinline__ bool next(int i, Unit& u) const {
        const int L = i * G + c;
        if (L < NU1) { u.e = 0; return pg8::static_order(L, NM1, NN1, u.pm, u.pn); }
        const int L2 = L - NU1; if (L2 >= NU2) return false;
        u.e = 1; u.pm = L2 >> 2; u.pn = L2 & 3; return true;
    }
    __device__ __forceinline__ const char* a_base(const Unit& u) const { return (const char*)(u.e ? MB : H) + (size_t)u.pm * 256 * D * 2; }
    __device__ __forceinline__ const char* b_base(const Unit& u) const { return (const char*)(u.e ? Wmkv : Win) + (size_t)u.pn * 256 * D * 2; }
    __device__ __forceinline__ void a_off(const Unit&, int, unsigned (&)[2][2]) const {}
    __device__ __forceinline__ void mid(f32x4 (&)[2][2][4][2], const Unit&, int, int, int, int, int) const {}
    __device__ __forceinline__ void epi(const f32x4 (&acc)[2][2][4][2], const Unit& u, int wr, int wc, int fr, int fq) const {
        if (u.e) epi_store_bf16(acc, MKV + (size_t)u.pm * 256 * 1024 + u.pn * 256, 1024, wr, wc, fr, fq);
        else epi_store_bf16(acc, Z + (size_t)u.pm * 256 * INW + u.pn * 256, INW, wr, wc, fr, fq);
    }
};


__device__ __forceinline__ int crow(int r, int hi) { return (r & 3) + 8 * (r >> 2) + 4 * hi; }
#define MFMA32(a, b, c) __builtin_amdgcn_mfma_f32_32x32x16_bf16((a), (b), (c), 0, 0, 0)
__device__ __forceinline__ float ret_log2g(int h) { return h == 0 ? -0.04580368961312479f : (h == 1 ? -0.02272007650008353f : (h == 2 ? -0.011315313227834146f : -0.005646563141142062f)); }
__device__ __forceinline__ void unpack8(const v4u w, float (&f)[8]) { f[0] = bf_lo(w.x); f[1] = bf_hi(w.x); f[2] = bf_lo(w.y); f[3] = bf_hi(w.y); f[4] = bf_lo(w.z); f[5] = bf_hi(w.z); f[6] = bf_lo(w.w); f[7] = bf_hi(w.w); }
__device__ __forceinline__ v4u pack8(const float (&f)[8]) { v4u w; w.x = cvt_pk_bf16(f[0], f[1]); w.y = cvt_pk_bf16(f[2], f[3]); w.z = cvt_pk_bf16(f[4], f[5]); w.w = cvt_pk_bf16(f[6], f[7]); return w; }
__device__ __forceinline__ bf16x8 as_bf16x8(v4u w) { return __builtin_bit_cast(bf16x8, w); }
__device__ __forceinline__ void st16(LAS unsigned char* p, unsigned short v) { *(LAS unsigned short*)p = v; }

__device__ __forceinline__ void rot16(const v4u la, const v4u lb, const v4u ha, const v4u hb, const float* cs, const float* sn, float scale, float (&o1)[16], float (&o2)[16]) {
    float t1[16], t2[16];
    { float f[8]; unpack8(la, f);
#pragma unroll
      for (int e = 0; e < 8; ++e) t1[e] = f[e]; unpack8(lb, f);
#pragma unroll
      for (int e = 0; e < 8; ++e) t1[8 + e] = f[e]; unpack8(ha, f);
#pragma unroll
      for (int e = 0; e < 8; ++e) t2[e] = f[e]; unpack8(hb, f);
#pragma unroll
      for (int e = 0; e < 8; ++e) t2[8 + e] = f[e]; }
#pragma unroll
    for (int q = 0; q < 4; ++q) { const f32x4 c4 = *(const GAS f32x4*)(cs + 4 * q), s4 = *(const GAS f32x4*)(sn + 4 * q);
#pragma unroll
        for (int e = 0; e < 4; ++e) { const float a = t1[4 * q + e], b = t2[4 * q + e]; o1[4 * q + e] = (a * c4[e] - b * s4[e]) * scale; o2[4 * q + e] = (a * s4[e] + b * c4[e]) * scale; } }
}

__device__ __forceinline__ void ret_scan_unit(Frame& F, int unit) {
    const int b = unit >> 4, h = (unit >> 2) & 3, dq = unit & 3;
    const bf16* Z = (const bf16*)(F.ws + WS_Z);
    const float* rc = (const float*)(F.ws + WS_ROPE); const float* rs = rc + SEQ * 64;
    bf16* ST = (bf16*)(F.ws + WS_ST) + (size_t)((b * 4 + h) * 16) * 256 * 128;
    const float l2g = ret_log2g(h), cd = exp2f(128.f * l2g);
    const int m = F.tid >> 2, cg = F.tid & 3;
    const int dvt = F.wave >> 2, dkt = F.wave & 3, r = F.lane & 31, hh = F.lane >> 5;
    LAS unsigned char* Kt = F.lds; LAS unsigned char* Vt = F.lds + 34816;
    f32x16 acc;
#pragma unroll
    for (int i = 0; i < 16; ++i) acc[i] = 0.f;
    const float kd = 0.08838834764831845f * exp2f((float)(127 - m) * l2g);
    for (int c = 0; c < 16; ++c) {
        { bf16* dst = ST + (size_t)c * 256 * 128 + (size_t)(dq * 64 + dvt * 32) * 128 + dkt * 32 + r;
#pragma unroll
          for (int i = 0; i < 16; ++i) dst[crow(i, hh) * 128] = (bf16)(cvt_pk_bf16(acc[i], 0.f) & 0xffffu); }
        if (c == 15) break;
        const size_t row = (size_t)(b * SEQ + c * 128 + m);
        const bf16* kp = Z + row * INW + C_RK + h * 128 + cg * 16;
        const v4u k1a = *(const GAS v4u*)kp, k1b = *(const GAS v4u*)(kp + 8), k2a = *(const GAS v4u*)(kp + 64), k2b = *(const GAS v4u*)(kp + 72);
        const bf16* vp = Z + row * INW + C_RV + h * 256 + dq * 64 + cg * 16;
        const v4u va = *(const GAS v4u*)vp, vb = *(const GAS v4u*)(vp + 8);
        float o1[16], o2[16];
        rot16(k1a, k1b, k2a, k2b, rc + (size_t)(c * 128 + m) * 64 + cg * 16, rs + (size_t)(c * 128 + m) * 64 + cg * 16, kd, o1, o2);
        __syncthreads();
#pragma unroll
        for (int e = 0; e < 16; e += 2) { const unsigned w1 = cvt_pk_bf16(o1[e], o1[e + 1]), w2 = cvt_pk_bf16(o2[e], o2[e + 1]);
            st16(Kt + (cg * 16 + e) * 272 + m * 2, (unsigned short)w1); st16(Kt + (cg * 16 + e + 1) * 272 + m * 2, (unsigned short)(w1 >> 16));
            st16(Kt + (64 + cg * 16 + e) * 272 + m * 2, (unsigned short)w2); st16(Kt + (64 + cg * 16 + e + 1) * 272 + m * 2, (unsigned short)(w2 >> 16)); }
        { const unsigned vw[8] = {va.x, va.y, va.z, va.w, vb.x, vb.y, vb.z, vb.w};
#pragma unroll
          for (int e = 0; e < 8; ++e) { st16(Vt + (cg * 16 + 2 * e) * 272 + m * 2, (unsigned short)vw[e]); st16(Vt + (cg * 16 + 2 * e + 1) * 272 + m * 2, (unsigned short)(vw[e] >> 16)); } }
        __syncthreads();
#pragma unroll
        for (int i = 0; i < 16; ++i) acc[i] *= cd;
#pragma unroll
        for (int ks = 0; ks < 8; ++ks) { const bf16x8 af = *(const LAS bf16x8*)(Vt + (dvt * 32 + r) * 272 + (ks * 16 + 8 * hh) * 2), bfr = *(const LAS bf16x8*)(Kt + (dkt * 32 + r) * 272 + (ks * 16 + 8 * hh) * 2);
            acc = MFMA32(af, bfr, acc); }
    }
    __syncthreads();
}

__device__ __forceinline__ void swa_unit(Frame& F, const Args& a, int unit) {
    const int b = unit >> 6, hk = (unit >> 5) & 1, qh = unit & 31, p0 = qh * 64;
    const bf16* Z = (const bf16*)(F.ws + WS_Z); bf16* OCb = (bf16*)(F.ws + WS_OC);
    LAS unsigned char* Kl = F.lds; LAS unsigned char* Vt = F.lds + 27648; LAS unsigned char* Ost = F.lds + 53248 + F.wave * 4608;
    const float* qw = a.in[5]; const float* kw = a.in[6];
#pragma unroll
    for (int i = 0; i < 3; ++i) { const int ci = F.tid + 512 * i, row = ci >> 3, ch = ci & 7, kp = p0 - 128 + row;
        v4u kq = (v4u){0u, 0u, 0u, 0u}, vq = (v4u){0u, 0u, 0u, 0u};
        if (kp >= 0) { const bf16* base = Z + (size_t)(b * SEQ + kp) * INW; kq = *(const GAS v4u*)(base + C_SK + hk * 64 + ch * 8); vq = *(const GAS v4u*)(base + C_SV + hk * 64 + ch * 8); }
        float f[8]; unpack8(kq, f); float ss = 0.f;
#pragma unroll
        for (int e = 0; e < 8; ++e) ss += f[e] * f[e];
        ss += __shfl_xor(ss, 1); ss += __shfl_xor(ss, 2); ss += __shfl_xor(ss, 4);
        const float rstd = 1.f / sqrtf(ss * (1.f / 64.f) + EPS);
        const f32x4 w0 = *(const GAS f32x4*)(kw + ch * 8), w1 = *(const GAS f32x4*)(kw + ch * 8 + 4);
#pragma unroll
        for (int e = 0; e < 4; ++e) { f[e] *= rstd * w0[e]; f[4 + e] *= rstd * w1[e]; }
        *(LAS v4u*)(Kl + row * 144 + ch * 16) = pack8(f);
        const unsigned vw[4] = {vq.x, vq.y, vq.z, vq.w};
#pragma unroll
        for (int e = 0; e < 4; ++e) { st16(Vt + (ch * 8 + 2 * e) * 400 + row * 2, (unsigned short)vw[e]); st16(Vt + (ch * 8 + 2 * e + 1) * 400 + row * 2, (unsigned short)(vw[e] >> 16)); } }
    const int g = F.wave >> 1, half = F.wave & 1, r = F.lane & 31, hh = F.lane >> 5;
    const int hq = hk * 4 + g, qi = 32 * half + r;
    bf16x8 qf[4];
    { const bf16* qb = Z + (size_t)(b * SEQ + p0 + qi) * INW + C_SQ + hq * 64 + 8 * hh;
      v4u raw[4]; float ss = 0.f;
#pragma unroll
      for (int ks = 0; ks < 4; ++ks) { raw[ks] = *(const GAS v4u*)(qb + ks * 16); float f[8]; unpack8(raw[ks], f);
#pragma unroll
          for (int e = 0; e < 8; ++e) ss += f[e] * f[e]; }
      ss += __shfl_xor(ss, 32);
      const float rstd = 0.125f / sqrtf(ss * (1.f / 64.f) + EPS);
#pragma unroll
      for (int ks = 0; ks < 4; ++ks) { float f[8]; unpack8(raw[ks], f); const f32x4 w0 = *(const GAS f32x4*)(qw + ks * 16 + 8 * hh), w1 = *(const GAS f32x4*)(qw + ks * 16 + 8 * hh + 4);
#pragma unroll
          for (int e = 0; e < 4; ++e) { f[e] *= rstd * w0[e]; f[4 + e] *= rstd * w1[e]; }
          qf[ks] = as_bf16x8(pack8(f)); } }
    __syncthreads();
    f32x16 s[6];
#pragma unroll
    for (int kb = 0; kb < 6; ++kb) {
#pragma unroll
        for (int i = 0; i < 16; ++i) s[kb][i] = 0.f;
#pragma unroll
        for (int ks = 0; ks < 4; ++ks) { const bf16x8 af = *(const LAS bf16x8*)(Kl + (32 * kb + r) * 144 + (ks * 16 + 8 * hh) * 2); s[kb] = MFMA32(af, qf[ks], s[kb]); } }
    const float sink = a.in[7][hq];
    float mx = sink;
#pragma unroll
    for (int kb = 0; kb < 6; ++kb)
#pragma unroll
        for (int i = 0; i < 16; ++i) { const int kj = 32 * kb + crow(i, hh); const bool valid = (kj > qi) && (kj <= qi + 128) && (p0 - 128 + kj >= 0);
            s[kb][i] = valid ? s[kb][i] : -1e30f; mx = fmaxf(mx, s[kb][i]); }
    mx = fmaxf(mx, __shfl_xor(mx, 32));
    float l = 0.f;
#pragma unroll
    for (int kb = 0; kb < 6; ++kb)
#pragma unroll
        for (int i = 0; i < 16; ++i) { const float pv = __expf(s[kb][i] - mx); s[kb][i] = pv; l += pv; }
    l += __shfl_xor(l, 32); l += __expf(sink - mx);
    f32x16 o[2];
#pragma unroll
    for (int dt = 0; dt < 2; ++dt)
#pragma unroll
        for (int i = 0; i < 16; ++i) o[dt][i] = 0.f;
#pragma unroll
    for (int kb = 0; kb < 6; ++kb)
#pragma unroll
        for (int s2 = 0; s2 < 2; ++s2) { v4u pw; pw.x = cvt_pk_bf16(s[kb][8 * s2 + 0], s[kb][8 * s2 + 1]); pw.y = cvt_pk_bf16(s[kb][8 * s2 + 2], s[kb][8 * s2 + 3]); pw.z = cvt_pk_bf16(s[kb][8 * s2 + 4], s[kb][8 * s2 + 5]); pw.w = cvt_pk_bf16(s[kb][8 * s2 + 6], s[kb][8 * s2 + 7]);
            const bf16x8 pf = as_bf16x8(pw);
#pragma unroll
            for (int dt = 0; dt < 2; ++dt) { const v2u lo = *(const LAS v2u*)(Vt + (32 * dt + r) * 400 + (32 * kb + 16 * s2 + 4 * hh) * 2), hi = *(const LAS v2u*)(Vt + (32 * dt + r) * 400 + (32 * kb + 16 * s2 + 8 + 4 * hh) * 2);
                o[dt] = MFMA32(as_bf16x8((v4u){lo.x, lo.y, hi.x, hi.y}), pf, o[dt]); } }
    const float inv = 1.f / l;
#pragma unroll
    for (int dt = 0; dt < 2; ++dt)
#pragma unroll
        for (int gq = 0; gq < 4; ++gq) { v2u w; w.x = cvt_pk_bf16(o[dt][4 * gq] * inv, o[dt][4 * gq + 1] * inv); w.y = cvt_pk_bf16(o[dt][4 * gq + 2] * inv, o[dt][4 * gq + 3] * inv);
            *(LAS v2u*)(Ost + r * 144 + (32 * dt + 8 * gq + 4 * hh) * 2) = w; }
    LDS_WAIT(); __builtin_amdgcn_wave_barrier();
#pragma unroll
    for (int i = 0; i < 4; ++i) { const int q = F.lane + 64 * i, row = q >> 3, ch = q & 7; const v4u v = *(const LAS v4u*)(Ost + row * 144 + ch * 16);
        *(GAS v4u*)(OCb + (size_t)(b * SEQ + p0 + 32 * half + row) * OC + hq * 64 + ch * 8) = v; }
    __syncthreads();
}

namespace ma {
constexpr int KVBLK = 64, LDQ = INW, LDK = 1024, LDO = OC;
constexpr float SCALE = 0.088388347648318440f, THR = 8.f;
constexpr int SHM_V = KVBLK * 128 * 2, SHM_K = KVBLK * 128 * 2;
#define MA_KSWZ(row, colB) ((row) * 256 + ((colB) ^ (((row) & 7) << 4)))
#define MA_SBAR() __builtin_amdgcn_sched_barrier(0)
__device__ __forceinline__ void partialSM(f32x16& p0, f32x16& p1, float& m_reg, float& mn, float& alpha) {
    constexpr float C = SCALE * 1.4426950408889634f;
    float pmax = p0[0];
#pragma unroll
    for (int r = 1; r < 16; ++r) pmax = fmaxf(pmax, p0[r]);
#pragma unroll
    for (int r = 0; r < 16; ++r) pmax = fmaxf(pmax, p1[r]);
    pmax = fmaxf(pmax, __shfl_xor(pmax, 32));
    if (__builtin_expect(__all(pmax - m_reg <= THR / SCALE), 1)) { mn = m_reg; alpha = 1.f; }
    else { mn = fmaxf(m_reg, pmax); alpha = __builtin_amdgcn_exp2f((m_reg - mn) * C); m_reg = mn; }
    const float mnC = -mn * C;
#pragma unroll
    for (int r = 0; r < 16; ++r) p0[r] = fmaf(p0[r], C, mnC);
#pragma unroll
    for (int r = 0; r < 16; ++r) p1[r] = fmaf(p1[r], C, mnC);
#pragma unroll
    for (int r = 0; r < 16; ++r) p0[r] = __builtin_amdgcn_exp2f(p0[r]);
}
__device__ __forceinline__ void finishSM(f32x16& p0, f32x16& p1, float alpha, float& l_reg, bf16x8& pa0, bf16x8& pa1, bf16x8& pa2, bf16x8& pa3) {
#pragma unroll
    for (int r = 0; r < 16; ++r) p1[r] = __builtin_amdgcn_exp2f(p1[r]);
    float ps = 0;
#pragma unroll
    for (int r = 0; r < 16; ++r) ps += p0[r];
#pragma unroll
    for (int r = 0; r < 16; ++r) ps += p1[r];
    ps += __shfl_xor(ps, 32);
    l_reg = l_reg * alpha + ps;
#define MA_PK4(P, BASE, OUT) do { unsigned a0 = cvt_pk_bf16(P[BASE + 0], P[BASE + 1]), a1 = cvt_pk_bf16(P[BASE + 2], P[BASE + 3]);   \
    unsigned b0 = cvt_pk_bf16(P[BASE + 4], P[BASE + 5]), b1 = cvt_pk_bf16(P[BASE + 6], P[BASE + 7]);                              \
    auto r0 = __builtin_amdgcn_permlane32_swap(a0, b0, false, false); auto r1 = __builtin_amdgcn_permlane32_swap(a1, b1, false, false); \
    v4u w = {r0[0], r1[0], r0[1], r1[1]}; OUT = as_bf16x8(w); } while (0)
    MA_PK4(p0, 0, pa0); MA_PK4(p0, 8, pa1); MA_PK4(p1, 0, pa2); MA_PK4(p1, 8, pa3);
#undef MA_PK4
}
__device__ __forceinline__ void qkt(f32x16& p0, f32x16& p1, const LAS unsigned char* Ks, const bf16x8* qr, int r32, int hi) {
#pragma unroll
    for (int r = 0; r < 16; ++r) { p0[r] = 0.f; p1[r] = 0.f; }
#pragma unroll
    for (int d0 = 0; d0 < 8; ++d0) { const int cb = (d0 * 16 + hi * 8) * 2;
        const bf16x8 b0 = *(const LAS bf16x8*)(Ks + MA_KSWZ(r32, cb));
        const bf16x8 b1 = *(const LAS bf16x8*)(Ks + MA_KSWZ(32 + r32, cb));
        p0 = MFMA32(b0, qr[d0], p0);
        p1 = MFMA32(b1, qr[d0], p1); }
}
__device__ __forceinline__ int v_st(int k, int c) { const int kk = (k & ~0xC) | ((k & 4) << 1) | ((k & 8) >> 1); return ((kk >> 3) * 4 + (c >> 5)) * 512 + ((kk & 7) * 32 + (c & 31)) * 2; }
__device__ __forceinline__ int v_rd_base(int lane) { return ((lane & 3) << 3) | (((lane >> 2) & 3) << 6) | (((lane >> 4) & 1) << 5) | (((lane >> 5) & 1) << 8); }
constexpr int v_rd_off(int d0, int ks, int half) { return d0 * 512 + ks * 4096 + half * 2048; }
template <int OFF> __device__ __forceinline__ s16x4 tr_read(int vb) {
    s16x4 r; asm volatile("ds_read_b64_tr_b16 %0, %1 offset:%2" : "=&v"(r) : "v"(vb), "i"(OFF) : "memory"); return r;
}
template <int D0> __device__ __forceinline__ void pv_one(f32x16& od, int vb, bf16x8 pa0, bf16x8 pa1, bf16x8 pa2, bf16x8 pa3) {
    const s16x4 l0 = tr_read<v_rd_off(D0, 0, 0)>(vb), h0 = tr_read<v_rd_off(D0, 0, 1)>(vb), l1 = tr_read<v_rd_off(D0, 1, 0)>(vb), h1 = tr_read<v_rd_off(D0, 1, 1)>(vb);
    const s16x4 l2 = tr_read<v_rd_off(D0, 2, 0)>(vb), h2 = tr_read<v_rd_off(D0, 2, 1)>(vb), l3 = tr_read<v_rd_off(D0, 3, 0)>(vb), h3 = tr_read<v_rd_off(D0, 3, 1)>(vb);
    asm volatile("s_waitcnt lgkmcnt(0)" ::: "memory"); MA_SBAR();
#define MA_PK(L, H) (bf16x8){L[0], L[1], L[2], L[3], H[0], H[1], H[2], H[3]}
    od = MFMA32(pa0, MA_PK(l0, h0), od);
    od = MFMA32(pa1, MA_PK(l1, h1), od);
    od = MFMA32(pa2, MA_PK(l2, h2), od);
    od = MFMA32(pa3, MA_PK(l3, h3), od);
#undef MA_PK
}
__device__ __forceinline__ void pv_d0(f32x16* o, int vb, bf16x8 pa0, bf16x8 pa1, bf16x8 pa2, bf16x8 pa3) {
    pv_one<0>(o[0], vb, pa0, pa1, pa2, pa3); pv_one<1>(o[1], vb, pa0, pa1, pa2, pa3); pv_one<2>(o[2], vb, pa0, pa1, pa2, pa3); pv_one<3>(o[3], vb, pa0, pa1, pa2, pa3);
}
__device__ __forceinline__ void body(const bf16* __restrict__ Qb, const bf16* __restrict__ Kh, const bf16* __restrict__ Vh, bf16* __restrict__ Ob, const float* qw, const float* kw, LAS unsigned char* lds) {
    const int tid = threadIdx.x, wid = tid >> 6, lane = tid & 63, r32 = lane & 31, hi = lane >> 5;
    LAS unsigned char* V_lds = lds; LAS unsigned char* K_lds = lds + 2 * SHM_V;
    LAS float* wsl = (LAS float*)(lds + 2 * SHM_V + 2 * SHM_K) + wid * 64; LAS float* li_l = wsl; LAS float* al_l = wsl + 32;
    float m_reg = -1e30f, l_reg = 0; f32x16 o[4]; bf16x8 qr[8];
#pragma unroll
    for (int d = 0; d < 4; ++d)
#pragma unroll
        for (int r = 0; r < 16; ++r) o[d][r] = 0.f;
    { const bf16* Qw = Qb + (size_t)(wid * 32 + r32) * LDQ + hi * 8; v4u raw[8]; float ss = 0.f;
#pragma unroll
      for (int d0 = 0; d0 < 8; ++d0) { raw[d0] = *(const GAS v4u*)(Qw + d0 * 16); float f[8]; unpack8(raw[d0], f);
#pragma unroll
          for (int e = 0; e < 8; ++e) ss += f[e] * f[e]; }
      ss += __shfl_xor(ss, 32);
      const float rstd = 1.f / sqrtf(ss * (1.f / 128.f) + EPS);
#pragma unroll
      for (int d0 = 0; d0 < 8; ++d0) { float f[8]; unpack8(raw[d0], f); const f32x4 w0 = *(const GAS f32x4*)(qw + d0 * 16 + hi * 8), w1 = *(const GAS f32x4*)(qw + d0 * 16 + hi * 8 + 4);
#pragma unroll
          for (int e = 0; e < 4; ++e) { f[e] *= rstd * w0[e]; f[4 + e] *= rstd * w1[e]; }
          qr[d0] = as_bf16x8(pack8(f)); } }
    const int sr = tid >> 4, sc = (tid & 15) * 8, vst0 = v_st(sr, sc), vst1 = v_st(32 + sr, sc);
    const int vb0 = (int)(uintptr_t)V_lds + v_rd_base(lane);
    const f32x4 kw0 = *(const GAS f32x4*)(kw + sc), kw1 = *(const GAS f32x4*)(kw + sc + 4);
    v4u s_vs0[2], s_vs1[2], s_ks0[2], s_ks1[2];
#define MA_SLOAD(i, k0) do { s_vs0[i] = *(const GAS v4u*)(&Vh[(size_t)((k0) + sr) * LDK + sc]); s_vs1[i] = *(const GAS v4u*)(&Vh[(size_t)((k0) + 32 + sr) * LDK + sc]); \
    s_ks0[i] = *(const GAS v4u*)(&Kh[(size_t)((k0) + sr) * LDK + sc]); s_ks1[i] = *(const GAS v4u*)(&Kh[(size_t)((k0) + 32 + sr) * LDK + sc]); } while (0)
#define MA_KNORM(x) ({ float f_[8]; unpack8((x), f_); float ss_ = 0.f; _Pragma("unroll") for (int e_ = 0; e_ < 8; ++e_) ss_ += f_[e_] * f_[e_]; \
    ss_ += __shfl_xor(ss_, 1); ss_ += __shfl_xor(ss_, 2); ss_ += __shfl_xor(ss_, 4); ss_ += __shfl_xor(ss_, 8); const float rs_ = 1.f / sqrtf(ss_ * (1.f / 128.f) + EPS); \
    _Pragma("unroll") for (int e_ = 0; e_ < 4; ++e_) { f_[e_] *= rs_ * kw0[e_]; f_[4 + e_] *= rs_ * kw1[e_]; } pack8(f_); })
#define MA_SWRITE(b, i) do { *(LAS v4u*)(V_lds + (b) * SHM_V + vst0) = s_vs0[i];          \
    *(LAS v4u*)(V_lds + (b) * SHM_V + vst1) = s_vs1[i]; const int kc = sc * 2;               \
    *(LAS v4u*)(K_lds + (b) * SHM_K + MA_KSWZ(sr, kc)) = MA_KNORM(s_ks0[i]);                       \
    *(LAS v4u*)(K_lds + (b) * SHM_K + MA_KSWZ(32 + sr, kc)) = MA_KNORM(s_ks1[i]); } while (0)
#define MA_SWAIT() asm volatile("s_waitcnt vmcnt(4)" ::: "memory")
#define MA_RESC(a) do { if (__any((a) < 1.f)) { if (hi == 0) al_l[r32] = (a); asm volatile("s_waitcnt lgkmcnt(0)" ::: "memory"); \
    _Pragma("unroll") for (int d = 0; d < 4; ++d) _Pragma("unroll") for (int r = 0; r < 16; ++r) o[d][r] *= al_l[crow(r, hi)]; } } while (0)
    f32x16 pA0, pA1, pB0, pB1; float mnA, mnB, alA, alB; bf16x8 pa0, pa1, pa2, pa3; constexpr int NT = MEMLEN / KVBLK;
    MA_SLOAD(0, 0); asm volatile("s_waitcnt vmcnt(0)" ::: "memory"); MA_SWRITE(0, 0); __syncthreads();
    qkt(pA0, pA1, K_lds, qr, r32, hi); partialSM(pA0, pA1, m_reg, mnA, alA);
    MA_SLOAD(1, KVBLK); MA_SLOAD(0, 2 * KVBLK);
    MA_SWAIT(); MA_SWRITE(1, 1); __syncthreads();
#pragma unroll 1
    for (int j = 1; j + 1 < NT; j += 2) {
        MA_SBAR(); qkt(pB0, pB1, K_lds + SHM_K, qr, r32, hi);
        finishSM(pA0, pA1, alA, l_reg, pa0, pa1, pa2, pa3); MA_SBAR();
        MA_SLOAD(1, (j + 2) * KVBLK); MA_SBAR();
        pv_d0(o, vb0, pa0, pa1, pa2, pa3); partialSM(pB0, pB1, m_reg, mnB, alB);
        __syncthreads(); MA_SWAIT(); MA_SWRITE(0, 0);
        MA_RESC(alB); __syncthreads();
        MA_SBAR(); qkt(pA0, pA1, K_lds, qr, r32, hi);
        finishSM(pB0, pB1, alB, l_reg, pa0, pa1, pa2, pa3); MA_SBAR();
        if (j + 3 < NT) MA_SLOAD(0, (j + 3) * KVBLK);
        MA_SBAR();
        pv_d0(o, vb0 + SHM_V, pa0, pa1, pa2, pa3); partialSM(pA0, pA1, m_reg, mnA, alA);
        __syncthreads(); asm volatile("s_waitcnt vmcnt(0)" ::: "memory"); MA_SWRITE(1, 1);
        MA_RESC(alA); __syncthreads();
    }
    MA_SBAR(); qkt(pB0, pB1, K_lds + SHM_K, qr, r32, hi);
    finishSM(pA0, pA1, alA, l_reg, pa0, pa1, pa2, pa3); MA_SBAR();
    pv_d0(o, vb0, pa0, pa1, pa2, pa3); partialSM(pB0, pB1, m_reg, mnB, alB);
    __syncthreads(); MA_RESC(alB);
    finishSM(pB0, pB1, alB, l_reg, pa0, pa1, pa2, pa3); MA_SBAR();
    pv_d0(o, vb0 + SHM_V, pa0, pa1, pa2, pa3);
    if (hi == 0) li_l[r32] = l_reg; asm volatile("s_waitcnt lgkmcnt(0)" ::: "memory");
    float rli[16];
#pragma unroll
    for (int r = 0; r < 16; ++r) rli[r] = __builtin_amdgcn_rcpf(li_l[crow(r, hi)]);
    bf16* Ow = Ob + (size_t)(wid * 32) * LDO;
#pragma unroll
    for (int r = 0; r < 16; ++r) { const int orow = crow(r, hi);
#pragma unroll
        for (int d0 = 0; d0 < 4; ++d0) Ow[(size_t)orow * LDO + d0 * 32 + r32] = (bf16)(cvt_pk_bf16(o[d0][r] * rli[r], 0.f) & 0xffffu); }
    __syncthreads();
#undef MA_SLOAD
#undef MA_SWRITE
#undef MA_SWAIT
#undef MA_RESC
#undef MA_KNORM
}
}

__device__ __forceinline__ void ret_out_unit(Frame& F, const Args& a, int unit) {
    const int b = unit >> 6, h = (unit >> 4) & 3, c = unit & 15;
    const bf16* Z = (const bf16*)(F.ws + WS_Z); bf16* OCb = (bf16*)(F.ws + WS_OC);
    const float* rc = (const float*)(F.ws + WS_ROPE); const float* rs = rc + SEQ * 64;
    const bf16* ST = (const bf16*)(F.ws + WS_ST) + (size_t)((b * 4 + h) * 16 + c) * 256 * 128;
    const float l2g = ret_log2g(h);
    LAS unsigned char* Ql = F.lds; LAS unsigned char* Kl = F.lds + 34816; LAS unsigned char* Vt = F.lds + 69632; LAS f32x2* stats = (LAS f32x2*)(F.lds + 139264); LAS unsigned char* Ost = F.lds;
    { const int m = F.tid >> 2, cg = F.tid & 3; const size_t row = (size_t)(b * SEQ + c * 128 + m);
      const float* cs = rc + (size_t)(c * 128 + m) * 64 + cg * 16; const float* sn = rs + (size_t)(c * 128 + m) * 64 + cg * 16;
      { const bf16* qp = Z + row * INW + C_RQ + h * 128 + cg * 16; float o1[16], o2[16];
        rot16(*(const GAS v4u*)qp, *(const GAS v4u*)(qp + 8), *(const GAS v4u*)(qp + 64), *(const GAS v4u*)(qp + 72), cs, sn, 1.f, o1, o2);
        float t[8];
#pragma unroll
        for (int q = 0; q < 2; ++q) {
#pragma unroll
            for (int e = 0; e < 8; ++e) t[e] = o1[8 * q + e];
            *(LAS v4u*)(Ql + m * 272 + (cg * 16 + 8 * q) * 2) = pack8(t);
#pragma unroll
            for (int e = 0; e < 8; ++e) t[e] = o2[8 * q + e];
            *(LAS v4u*)(Ql + m * 272 + (64 + cg * 16 + 8 * q) * 2) = pack8(t); } }
      { const bf16* kp = Z + row * INW + C_RK + h * 128 + cg * 16; float o1[16], o2[16];
        rot16(*(const GAS v4u*)kp, *(const GAS v4u*)(kp + 8), *(const GAS v4u*)(kp + 64), *(const GAS v4u*)(kp + 72), cs, sn, 0.08838834764831845f, o1, o2);
        float t[8];
#pragma unroll
        for (int q = 0; q < 2; ++q) {
#pragma unroll
            for (int e = 0; e < 8; ++e) t[e] = o1[8 * q + e];
            *(LAS v4u*)(Kl + m * 272 + (cg * 16 + 8 * q) * 2) = pack8(t);
#pragma unroll
            for (int e = 0; e < 8; ++e) t[e] = o2[8 * q + e];
            *(LAS v4u*)(Kl + m * 272 + (64 + cg * 16 + 8 * q) * 2) = pack8(t); } }
      const bf16* vp = Z + row * INW + C_RV + h * 256 + cg * 64;
#pragma unroll
      for (int q = 0; q < 8; ++q) { const v4u vv = *(const GAS v4u*)(vp + 8 * q); const unsigned vw[4] = {vv.x, vv.y, vv.z, vv.w};
#pragma unroll
          for (int e = 0; e < 4; ++e) { st16(Vt + (cg * 64 + 8 * q + 2 * e) * 272 + m * 2, (unsigned short)vw[e]); st16(Vt + (cg * 64 + 8 * q + 2 * e + 1) * 272 + m * 2, (unsigned short)(vw[e] >> 16)); } } }
    __syncthreads();
    const int lb = F.wave & 3, dh = F.wave >> 2, r = F.lane & 31, hh = F.lane >> 5, l = 32 * lb + r;
    bf16x8 qb[8];
#pragma unroll
    for (int ks = 0; ks < 8; ++ks) qb[ks] = *(const LAS bf16x8*)(Ql + l * 272 + (ks * 16 + 8 * hh) * 2);
    f32x16 o[4];
#pragma unroll
    for (int dt = 0; dt < 4; ++dt)
#pragma unroll
        for (int i = 0; i < 16; ++i) o[dt][i] = 0.f;
    if (c > 0) {
#pragma unroll
        for (int dt = 0; dt < 4; ++dt) { const bf16* sp = ST + (size_t)(dh * 128 + 32 * dt + r) * 128 + 8 * hh;
#pragma unroll
            for (int ks = 0; ks < 8; ++ks) { const bf16x8 af = as_bf16x8(*(const GAS v4u*)(sp + ks * 16)); o[dt] = MFMA32(af, qb[ks], o[dt]); } }
        const float qd = exp2f((float)(l + 1) * l2g);
#pragma unroll
        for (int dt = 0; dt < 4; ++dt)
#pragma unroll
            for (int i = 0; i < 16; ++i) o[dt][i] *= qd;
    }
#pragma unroll 1
    for (int mb = 0; mb <= lb; ++mb) {
        f32x16 s;
#pragma unroll
        for (int i = 0; i < 16; ++i) s[i] = 0.f;
#pragma unroll
        for (int ks = 0; ks < 8; ++ks) { const bf16x8 af = *(const LAS bf16x8*)(Kl + (32 * mb + r) * 272 + (ks * 16 + 8 * hh) * 2); s = MFMA32(af, qb[ks], s); }
#pragma unroll
        for (int i = 0; i < 16; ++i) { const int m = 32 * mb + crow(i, hh); s[i] = (l >= m) ? s[i] * exp2f((float)(l - m) * l2g) : 0.f; }
#pragma unroll
        for (int s2 = 0; s2 < 2; ++s2) { v4u pw; pw.x = cvt_pk_bf16(s[8 * s2 + 0], s[8 * s2 + 1]); pw.y = cvt_pk_bf16(s[8 * s2 + 2], s[8 * s2 + 3]); pw.z = cvt_pk_bf16(s[8 * s2 + 4], s[8 * s2 + 5]); pw.w = cvt_pk_bf16(s[8 * s2 + 6], s[8 * s2 + 7]);
            const bf16x8 pf = as_bf16x8(pw);
#pragma unroll
            for (int dt = 0; dt < 4; ++dt) { const LAS unsigned char* vr = Vt + (dh * 128 + 32 * dt + r) * 272 + (32 * mb + 16 * s2 + 4 * hh) * 2;
                const v2u lo = *(const LAS v2u*)vr, hi = *(const LAS v2u*)(vr + 16);
                o[dt] = MFMA32(as_bf16x8((v4u){lo.x, lo.y, hi.x, hi.y}), pf, o[dt]); } }
    }
    float sm = 0.f, sq = 0.f;
#pragma unroll
    for (int dt = 0; dt < 4; ++dt)
#pragma unroll
        for (int i = 0; i < 16; ++i) { sm += o[dt][i]; sq += o[dt][i] * o[dt][i]; }
    sm += __shfl_xor(sm, 32); sq += __shfl_xor(sq, 32);
    if (hh == 0) stats[dh * 128 + l] = (f32x2){sm, sq};
    __syncthreads();
    { const f32x2 s0 = stats[l], s1 = stats[128 + l]; const float mean = (s0.x + s1.x) * (1.f / 256.f); const float var = fmaxf((s0.y + s1.y) * (1.f / 256.f) - mean * mean, 0.f);
      const float rstd = 1.f / sqrtf(var + EPS); const float* nw = a.in[8] + h * 256 + dh * 128;
#pragma unroll
      for (int dt = 0; dt < 4; ++dt)
#pragma unroll
          for (int gq = 0; gq < 4; ++gq) { const int dvl = 32 * dt + 8 * gq + 4 * hh; const f32x4 w4 = *(const GAS f32x4*)(nw + dvl);
              v2u w; w.x = cvt_pk_bf16((o[dt][4 * gq] - mean) * rstd * w4[0], (o[dt][4 * gq + 1] - mean) * rstd * w4[1]); w.y = cvt_pk_bf16((o[dt][4 * gq + 2] - mean) * rstd * w4[2], (o[dt][4 * gq + 3] - mean) * rstd * w4[3]);
              *(LAS v2u*)(Ost + l * 528 + (dh * 128 + dvl) * 2) = w; } }
    __syncthreads();
#pragma unroll
    for (int i = 0; i < 8; ++i) { const int id = F.tid + 512 * i, row = id >> 5, ch = id & 31; const size_t grow = (size_t)(b * SEQ + c * 128 + row);
        const v4u ov = *(const LAS v4u*)(Ost + row * 528 + ch * 16); const v4u gv = *(const GAS v4u*)(Z + grow * INW + C_RG + h * 256 + ch * 8);
        float fo[8], fg[8]; unpack8(ov, fo); unpack8(gv, fg);
#pragma unroll
        for (int e = 0; e < 8; ++e) fo[e] *= fg[e] * sigmoidf_(fg[e]);
        *(GAS v4u*)(OCb + grow * OC + 512 + h * 256 + ch * 8) = pack8(fo); }
    __syncthreads();
}


struct P4Policy {
    static constexpr bool PERM = true, GATHER = false, HAS_MID = true;
    int K, G, c; const bf16 *OCb, *Wbr, *Z; bf16* MG;
    __device__ __forceinline__ bool next(int i, Unit& u) const { u.e = 0; return pg8::static_order(i * G + c, T / 256, 4, u.pm, u.pn); }
    __device__ __forceinline__ const char* a_base(const Unit& u) const { return (const char*)OCb + (size_t)u.pm * 256 * OC * 2; }
    __device__ __forceinline__ const char* b_base(const Unit& u) const { return (const char*)Wbr + (size_t)u.pn * 256 * OC * 2; }
    __device__ __forceinline__ void a_off(const Unit&, int, unsigned (&)[2][2]) const {}
    __device__ __forceinline__ void mid(f32x4 (&acc)[2][2][4][2], const Unit& u, int t, int wr, int wc, int fr, int fq) const {
        if (t != 8 && t != 24) return;
        const int br = (t == 8) ? 0 : 1;
        const bf16* zb = Z + (size_t)(u.pm * 256 + wr * 64 + fr) * INW + C_ZG + br * 1024 + u.pn * 256 + wc * 32 + 8 * fq;
#pragma unroll
        for (int ai = 0; ai < 2; ++ai) { v4u ga[4][2], gb[4][2];
#pragma unroll
            for (int m = 0; m < 4; ++m)
#pragma unroll
                for (int bj = 0; bj < 2; ++bj) { const bf16* zr = zb + (size_t)(ai * 128 + m * 16) * INW + bj * 128; ga[m][bj] = *(const GAS v4u*)zr; gb[m][bj] = *(const GAS v4u*)(zr + 1024); }
#pragma unroll
            for (int m = 0; m < 4; ++m)
#pragma unroll
                for (int bj = 0; bj < 2; ++bj) { float fa[8], fb[8]; unpack8(ga[m][bj], fa); unpack8(gb[m][bj], fb); float rt[8];
#pragma unroll
                    for (int e = 0; e < 8; ++e) rt[e] = (1.f + __expf(-fb[e])) * __builtin_amdgcn_rcpf(1.f + __expf(-fa[e]));
                    acc[ai][bj][m][0] *= (f32x4){rt[0], rt[1], rt[2], rt[3]}; acc[ai][bj][m][1] *= (f32x4){rt[4], rt[5], rt[6], rt[7]}; }
            asm volatile("" ::: "memory"); }
    }
    __device__ __forceinline__ void epi(f32x4 (&acc)[2][2][4][2], const Unit& u, int wr, int wc, int fr, int fq) const {
        const bf16* zb = Z + (size_t)(u.pm * 256 + wr * 64 + fr) * INW + C_ZG + 2 * 1024 + u.pn * 256 + wc * 32 + 8 * fq;
        bf16* ob = MG + (size_t)(u.pm * 256 + wr * 64 + fr) * D + u.pn * 256 + wc * 32 + 8 * fq;
#pragma unroll
        for (int ai = 0; ai < 2; ++ai) { v4u ga[4][2];
#pragma unroll
            for (int m = 0; m < 4; ++m)
#pragma unroll
                for (int bj = 0; bj < 2; ++bj) ga[m][bj] = *(const GAS v4u*)(zb + (size_t)(ai * 128 + m * 16) * INW + bj * 128);
#pragma unroll
            for (int m = 0; m < 4; ++m)
#pragma unroll
                for (int bj = 0; bj < 2; ++bj) { float fa[8]; unpack8(ga[m][bj], fa); float r[8];
#pragma unroll
                    for (int e = 0; e < 4; ++e) { r[e] = acc[ai][bj][m][0][e] * sigmoidf_(fa[e]); r[4 + e] = acc[ai][bj][m][1][e] * sigmoidf_(fa[4 + e]); }
                    *(GAS v4u*)(ob + (size_t)(ai * 128 + m * 16) * D + bj * 128) = pack8(r); }
            asm volatile("" ::: "memory"); }
    }
};
struct P5Policy {
    static constexpr bool PERM = false, GATHER = false, HAS_MID = false;
    int K, G, c; const bf16 *MG, *Wout; const float* X; float* OUT;
    __device__ __forceinline__ bool next(int i, Unit& u) const { u.e = 0; return pg8::static_order(i * G + c, T / 256, 4, u.pm, u.pn); }
    __device__ __forceinline__ const char* a_base(const Unit& u) const { return (const char*)MG + (size_t)u.pm * 256 * D * 2; }
    __device__ __forceinline__ const char* b_base(const Unit& u) const { return (const char*)Wout + (size_t)u.pn * 256 * D * 2; }
    __device__ __forceinline__ void a_off(const Unit&, int, unsigned (&)[2][2]) const {}
    __device__ __forceinline__ void mid(f32x4 (&)[2][2][4][2], const Unit&, int, int, int, int, int) const {}
    __device__ __forceinline__ void epi(f32x4 (&acc)[2][2][4][2], const Unit& u, int wr, int wc, int fr, int fq) const {
        const size_t off0 = (size_t)(u.pm * 256 + wr * 64 + fr) * D + u.pn * 256 + wc * 32 + 4 * fq;
#pragma unroll
        for (int ai = 0; ai < 2; ++ai) { f32x4 xv[4][2][2];
#pragma unroll
            for (int m = 0; m < 4; ++m)
#pragma unroll
                for (int bj = 0; bj < 2; ++bj)
#pragma unroll
                    for (int n = 0; n < 2; ++n) xv[m][bj][n] = *(const GAS f32x4*)(X + off0 + (size_t)(ai * 128 + m * 16) * D + bj * 128 + n * 16);
#pragma unroll
            for (int m = 0; m < 4; ++m)
#pragma unroll
                for (int bj = 0; bj < 2; ++bj)
#pragma unroll
                    for (int n = 0; n < 2; ++n) *(GAS f32x4*)(OUT + off0 + (size_t)(ai * 128 + m * 16) * D + bj * 128 + n * 16) = xv[m][bj][n] + acc[ai][bj][m][n];
            asm volatile("" ::: "memory"); }
    }
};
__device__ __forceinline__ void p6_router(Frame& F, const Args& a) {
    LAS float* WrT = (LAS float*)F.lds;
    LAS int* sel_e = (LAS int*)(F.lds + 131072); LAS float* sel_g = (LAS float*)(F.lds + 131072 + 2048); LAS int* sel_p = (LAS int*)(F.lds + 131072 + 4096);
    LAS int* lcnt = (LAS int*)(F.lds + 131072 + 6144); LAS int* lbase = (LAS int*)(F.lds + 131072 + 6144 + 128);
    { const float* wrt = (const float*)(F.ws + WS_WR);
#pragma unroll 4
      for (int i = 0; i < 16; ++i) { const int o = (F.tid + 512 * i) * 4; *(LAS f32x4*)(WrT + o) = *(const GAS f32x4*)(wrt + o); } }
    const float* gain = a.in[16]; const float* brt = a.in[18];
    bf16* H2 = (bf16*)(F.ws + WS_H); int* list = (int*)(F.ws + WS_LIST); float* gate_tk = (float*)(F.ws + WS_GATE);
    unsigned* gcnt = (unsigned*)(F.ctl + CW_CNT);
    const int lane = F.lane;
    f32x4 gn[4];
#pragma unroll
    for (int j = 0; j < 4; ++j) gn[j] = *(const GAS f32x4*)(gain + 4 * lane + 256 * j);
    const float mybias = brt[lane & 31];
    for (int chunk = F.bid; chunk < T / 128; chunk += F.G) {
        if (F.tid < 32) lcnt[F.tid] = 0;
        __syncthreads();
#pragma unroll 1
        for (int grp = 0; grp < 4; ++grp) {
            const int rl0 = F.wave * 16 + grp * 4; const int row0 = chunk * 128 + rl0;
            f32x4 hv[4][4];
#pragma unroll
            for (int rr = 0; rr < 4; ++rr) { const GAS f32x4* xr = (const GAS f32x4*)(a.out + (size_t)(row0 + rr) * D) + lane; float ss = 0.f;
#pragma unroll
                for (int j = 0; j < 4; ++j) { hv[rr][j] = xr[64 * j]; ss += (hv[rr][j].x * hv[rr][j].x + hv[rr][j].y * hv[rr][j].y) + (hv[rr][j].z * hv[rr][j].z + hv[rr][j].w * hv[rr][j].w); }
                const float rstd = 1.f / sqrtf(wave_sum(ss) * (1.f / D) + EPS);
                GAS v2u* o8 = (GAS v2u*)(H2 + (size_t)(row0 + rr) * D) + lane;
#pragma unroll
                for (int j = 0; j < 4; ++j) { hv[rr][j] = hv[rr][j] * rstd * gn[j]; v2u o; o.x = cvt_pk_bf16(hv[rr][j].x, hv[rr][j].y); o.y = cvt_pk_bf16(hv[rr][j].z, hv[rr][j].w); o8[64 * j] = o; } }
            float lg[4] = {0.f, 0.f, 0.f, 0.f};
#pragma unroll 1
            for (int e = 0; e < NE; ++e) { f32x4 w4[4];
#pragma unroll
                for (int j = 0; j < 4; ++j) w4[j] = *(const LAS f32x4*)(WrT + e * 1024 + 4 * lane + 256 * j);
#pragma unroll
                for (int rr = 0; rr < 4; ++rr) { float p = 0.f;
#pragma unroll
                    for (int j = 0; j < 4; ++j) p += (hv[rr][j].x * w4[j].x + hv[rr][j].y * w4[j].y) + (hv[rr][j].z * w4[j].z + hv[rr][j].w * w4[j].w);
                    p = wave_sum(p); lg[rr] = ((lane & 31) == e) ? p : lg[rr]; } }
#pragma unroll
            for (int rr = 0; rr < 4; ++rr) {
                float val = (lane < 32) ? lg[rr] + mybias : -3.0e38f; float tv[4]; int ti[4];
#pragma unroll
                for (int k = 0; k < 4; ++k) { float mv = val; int mi = lane;
#pragma unroll
                    for (int o = 1; o < 64; o <<= 1) { const float ov = __shfl_xor(mv, o); const int oi = __shfl_xor(mi, o); const bool take = (ov > mv) || (ov == mv && oi < mi); mv = take ? ov : mv; mi = take ? oi : mi; }
                    tv[k] = mv; ti[k] = mi; val = (lane == mi) ? -3.0e38f : val; }
                const float e1 = __expf(tv[1] - tv[0]), e2 = __expf(tv[2] - tv[0]), e3 = __expf(tv[3] - tv[0]); const float inv = 1.f / (1.f + e1 + e2 + e3);
                if (lane < 4) { const int ek = lane == 0 ? ti[0] : (lane == 1 ? ti[1] : (lane == 2 ? ti[2] : ti[3])); const float gk = (lane == 0 ? 1.f : (lane == 1 ? e1 : (lane == 2 ? e2 : e3))) * inv;
                    const int pos = atomicAdd((int*)(lcnt + ek), 1); const int sl = (rl0 + rr) * 4 + lane; sel_e[sl] = ek; sel_g[sl] = gk; sel_p[sl] = pos; } }
        }
        __syncthreads();
        if (F.tid < 32) lbase[F.tid] = (int)__hip_atomic_fetch_add(gcnt + F.tid, (unsigned)lcnt[F.tid], RLX_AGENT);
        __syncthreads();
        { const int e = sel_e[F.tid], pos = lbase[e] + sel_p[F.tid]; const int dest = (chunk * 128 + (F.tid >> 2)) * 4 + (F.tid & 3);
          list[(size_t)e * LCAP + pos] = dest; gate_tk[dest] = sel_g[F.tid]; }
        __syncthreads();
    }
}
__device__ __forceinline__ void moe_table(Frame& F) {
    if (F.tid < 32) F.MISC[64 + F.tid] = __hip_atomic_load(F.ctl + CW_CNT + F.tid, RLX_AGENT);
    __syncthreads();
    if (F.tid == 0) { unsigned s = 0; for (int e = 0; e < NE; ++e) { F.MISC[16 + e] = s; s += (F.MISC[64 + e] + 255u) >> 8; } F.MISC[16 + NE] = s; }
    __syncthreads();
}
template <int NPN>
__device__ __forceinline__ bool moe_next(volatile LAS unsigned* MISC, int L, Unit& u) {
    const int total = (int)MISC[16 + NE] * NPN; if (L >= total) return false;
    const int tile = L / NPN; u.pn = L % NPN; int e = 0;
#pragma unroll 1
    for (int k = 1; k < NE; ++k) e = ((int)MISC[16 + k] <= tile) ? k : e;
    u.e = e; u.pm = tile; u.x = tile - (int)MISC[16 + e]; return true;
}
struct P7Policy {
    static constexpr bool PERM = true, GATHER = true, HAS_MID = false;
    int K, G, c; const bf16 *H2, *Wup; bf16* ACT; const int* list; const float* bup; volatile LAS unsigned* MISC;
    __device__ __forceinline__ bool next(int i, Unit& u) const { return moe_next<8>(MISC, i * G + c, u); }
    __device__ __forceinline__ const char* a_base(const Unit&) const { return (const char*)H2; }
    __device__ __forceinline__ const char* b_base(const Unit& u) const { return (const char*)Wup + ((size_t)u.e * 2048 + (size_t)u.pn * 256) * D * 2; }
    __device__ __forceinline__ void a_off(const Unit& u, int tid, unsigned (&v)[2][2]) const {
        const int cnt = (int)MISC[64 + u.e];
#pragma unroll
        for (int i = 0; i < 2; ++i) { int R, C; pg8::stage_rc(tid * 16 + i * 8192, R, C);
#pragma unroll
            for (int h = 0; h < 2; ++h) { const int idx = u.x * 256 + h * 128 + R; const int tok = (idx < cnt) ? (list[(size_t)u.e * LCAP + idx] >> 2) : 0; v[h][i] = (unsigned)tok * (unsigned)(D * 2) + (unsigned)(C * 2); } }
    }
    __device__ __forceinline__ void mid(f32x4 (&)[2][2][4][2], const Unit&, int, int, int, int, int) const {}
    __device__ __forceinline__ void epi(f32x4 (&acc)[2][2][4][2], const Unit& u, int wr, int wc, int fr, int fq) const {
        const int oc0 = u.pn * 128 + wc * 32 + 8 * fq;
        const float* bp = bup + (size_t)u.e * 2048 + 2 * oc0;
        f32x4 bb[4];
#pragma unroll
        for (int q = 0; q < 4; ++q) bb[q] = *(const GAS f32x4*)(bp + 4 * q);
        bf16* ob = ACT + (size_t)(u.pm * 256 + wr * 64 + fr) * DFF + oc0;
#pragma unroll
        for (int ai = 0; ai < 2; ++ai)
#pragma unroll
            for (int m = 0; m < 4; ++m) { float r[8];
#pragma unroll
                for (int n = 0; n < 2; ++n)
#pragma unroll
                    for (int q = 0; q < 4; ++q) { const int j = 4 * n + q;
                        const float bg = bb[(2 * j) >> 2][(2 * j) & 3], bl = bb[(2 * j + 1) >> 2][(2 * j + 1) & 3];
                        const float xg = fminf(acc[ai][0][m][n][q] + bg, 7.f), xl = fminf(fmaxf(acc[ai][1][m][n][q] + bl, -7.f), 7.f);
                        r[j] = xg * sigmoidf_(1.702f * xg) * (xl + 1.f); }
                *(GAS v4u*)(ob + (size_t)(ai * 128 + m * 16) * DFF) = pack8(r); }
    }
};
struct P8Policy {
    static constexpr bool PERM = true, GATHER = false, HAS_MID = false;
    int K, G, c; const bf16 *ACT, *Wdn; bf16* Y; const int* list; const float* gate_tk; const float* bdn; volatile LAS unsigned* MISC;
    __device__ __forceinline__ bool next(int i, Unit& u) const { return moe_next<4>(MISC, i * G + c, u); }
    __device__ __forceinline__ const char* a_base(const Unit& u) const { return (const char*)ACT + (size_t)u.pm * 256 * DFF * 2; }
    __device__ __forceinline__ const char* b_base(const Unit& u) const { return (const char*)Wdn + ((size_t)u.e * 1024 + (size_t)u.pn * 256) * DFF * 2; }
    __device__ __forceinline__ void a_off(const Unit&, int, unsigned (&)[2][2]) const {}
    __device__ __forceinline__ void mid(f32x4 (&)[2][2][4][2], const Unit&, int, int, int, int, int) const {}
    __device__ __forceinline__ void epi(f32x4 (&acc)[2][2][4][2], const Unit& u, int wr, int wc, int fr, int fq) const {
        const int cnt = (int)MISC[64 + u.e]; const int c0 = u.pn * 256 + wc * 32 + 8 * fq;
        f32x4 bb[2][2];
#pragma unroll
        for (int bj = 0; bj < 2; ++bj)
#pragma unroll
            for (int n = 0; n < 2; ++n) bb[bj][n] = *(const GAS f32x4*)(bdn + (size_t)u.e * 1024 + c0 + bj * 128 + 4 * n);
#pragma unroll
        for (int ai = 0; ai < 2; ++ai)
#pragma unroll
            for (int m = 0; m < 4; ++m) { const int idx = u.x * 256 + ai * 128 + wr * 64 + m * 16 + fr;
                if (idx < cnt) { const int dest = list[(size_t)u.e * LCAP + idx]; const float gt = gate_tk[dest]; bf16* yp = Y + (size_t)dest * D + c0;
#pragma unroll
                    for (int bj = 0; bj < 2; ++bj) { float r[8];
#pragma unroll
                        for (int q = 0; q < 4; ++q) { r[q] = (acc[ai][bj][m][0][q] + bb[bj][0][q]) * gt; r[4 + q] = (acc[ai][bj][m][1][q] + bb[bj][1][q]) * gt; }
                        *(GAS v4u*)(yp + bj * 128) = pack8(r); } } }
    }
};
__device__ __forceinline__ void p9_combine(Frame& F, const Args& a) {
    const bf16* Y = (const bf16*)(F.ws + WS_Y);
    const int gw = F.bid * NWAVES + F.wave, NGW = F.G * NWAVES;
    for (int t = gw; t < T; t += NGW) {
        GAS f32x4* xr = (GAS f32x4*)(a.out + (size_t)t * D) + F.lane;
        f32x4 v[4];
#pragma unroll
        for (int j = 0; j < 4; ++j) v[j] = xr[64 * j];
#pragma unroll
        for (int k = 0; k < 4; ++k) { const GAS v2u* yr = (const GAS v2u*)(Y + ((size_t)t * 4 + k) * D) + F.lane;
#pragma unroll
            for (int j = 0; j < 4; ++j) { const v2u w = yr[64 * j]; v[j] += (f32x4){bf_lo(w.x), bf_hi(w.x), bf_lo(w.y), bf_hi(w.y)}; } }
#pragma unroll
        for (int j = 0; j < 4; ++j) xr[64 * j] = v[j];
    }
}

__global__ void __launch_bounds__(NWAVES * 64, 2) fwd(Args args) {
    extern __shared__ __attribute__((aligned(16))) unsigned char lds[];
    Frame F;
    F.lds = (LAS unsigned char*)lds;
    F.MISC = (volatile LAS unsigned*)(F.lds + MISC_OFF);
    F.tid = threadIdx.x; F.lane = F.tid & 63; F.wave = __builtin_amdgcn_readfirstlane(F.tid >> 6);
    F.G = gridDim.x; F.bid = blockIdx.x; F.ws = args.ws;
    F.ctl = (gu32*)(args.ws + WS_CTL);
    for (int u = F.tid; u < 256; u += NWAVES * 64) ((LAS unsigned*)(F.lds + MISC_OFF))[u] = 0u;
    __syncthreads();
    const int lo = args.ph_lo, hi = args.ph_hi;
    const bool multi = (hi - lo) > 1;
    XcdBarrier bar; bar.bar = (unsigned*)(F.ctl + CW_BAR) + args.li * XCD_BAR_WORDS; bar.x = 0; bar.st = nullptr;
    if (multi) bar = xcd_barrier_post((unsigned*)(F.ctl + CW_BAR) + args.li * XCD_BAR_WORDS, F.MISC);
#define IN(k) (lo <= (k) && (k) < hi)
#define SEAM(k) do { if (IN(k) && IN((k) + 1)) xcd_barrier(bar); } while (0)

    if (IN(0)) { p0_prologue(F, args); }
    SEAM(0);
    if (IN(1)) {
        P1Policy p; p.K = D; p.G = F.G; p.c = F.bid; p.H = (const bf16*)(F.ws + WS_H); p.MB = (const bf16*)(F.ws + WS_MB); p.Win = (const bf16*)(F.ws + WS_WIN); p.Wmkv = (const bf16*)(F.ws + WS_WMKV);
        p.Z = (bf16*)(F.ws + WS_Z); p.MKV = (bf16*)(F.ws + WS_MKV);
        pg8::gemm_phase(F.lds, p);
    }
    SEAM(1);
    if (IN(2)) {
        for (int u = F.bid; u < 256; u += F.G) ret_scan_unit(F, u);
        for (int u = F.bid; u < 1024; u += F.G) swa_unit(F, args, u);
        for (int u = F.bid; u < 512; u += F.G) { const int b = u >> 5, h = (u >> 3) & 3, qb = u & 7;
            const bf16* Z = (const bf16*)(F.ws + WS_Z); const bf16* MKV = (const bf16*)(F.ws + WS_MKV); bf16* OCb = (bf16*)(F.ws + WS_OC);
            ma::body(Z + (size_t)(b * SEQ + qb * 256) * INW + C_MQ + h * 128, MKV + (size_t)(b * MEMLEN) * 1024 + h * 128, MKV + (size_t)(b * MEMLEN) * 1024 + 512 + h * 128,
                     OCb + (size_t)(b * SEQ + qb * 256) * OC + 1536 + h * 128, args.in[10], args.in[11], F.lds); }
    }
    SEAM(2);
    if (IN(3)) { for (int u = F.bid; u < 1024; u += F.G) ret_out_unit(F, args, u); }
    SEAM(3);
    if (IN(4)) {
        P4Policy p; p.K = OC; p.G = F.G; p.c = F.bid; p.OCb = (const bf16*)(F.ws + WS_OC); p.Wbr = (const bf16*)(F.ws + WS_WBR); p.Z = (const bf16*)(F.ws + WS_Z); p.MG = (bf16*)(F.ws + WS_H);
        pg8::gemm_phase(F.lds, p);
    }
    SEAM(4);
    if (IN(5)) {
        P5Policy p; p.K = D; p.G = F.G; p.c = F.bid; p.MG = (const bf16*)(F.ws + WS_H); p.Wout = (const bf16*)(F.ws + WS_WOUT); p.X = args.in[0]; p.OUT = args.out;
        pg8::gemm_phase(F.lds, p);
    }
    SEAM(5);
    if (IN(6)) { p6_router(F, args); }
    SEAM(6);
    if (IN(7)) {
        moe_table(F);
        P7Policy p; p.K = D; p.G = F.G; p.c = F.bid; p.H2 = (const bf16*)(F.ws + WS_H); p.Wup = (const bf16*)(F.ws + WS_WUP); p.ACT = (bf16*)(F.ws + WS_ACT); p.list = (const int*)(F.ws + WS_LIST); p.bup = args.in[20]; p.MISC = F.MISC;
        pg8::gemm_phase(F.lds, p);
    }
    SEAM(7);
    if (IN(8)) {
        moe_table(F);
        P8Policy p; p.K = DFF; p.G = F.G; p.c = F.bid; p.ACT = (const bf16*)(F.ws + WS_ACT); p.Wdn = (const bf16*)(F.ws + WS_WDN); p.Y = (bf16*)(F.ws + WS_Y); p.list = (const int*)(F.ws + WS_LIST);
        p.gate_tk = (const float*)(F.ws + WS_GATE); p.bdn = args.in[22]; p.MISC = F.MISC;
        pg8::gemm_phase(F.lds, p);
    }
    SEAM(8);
    if (IN(9)) { p9_combine(F, args); }
#undef IN
#undef SEAM
}

extern "C" void kernel_launch(void* const* d_in, const int* in_sizes, int n_in, void* d_out, int out_size, void* d_ws, size_t ws_size, hipStream_t stream) {
    static int grid = 0;
    if (grid == 0) {
        if (n_in != 23 || out_size != T * D || ws_size < WS_END) { fprintf(stderr, "kernel_launch: unexpected shapes (n_in %d out %d ws %zu)\n", n_in, out_size, ws_size); grid = -1; return; }
        int dev = 0, cus = 0;
        if (hipGetDevice(&dev) != hipSuccess || hipDeviceGetAttribute(&cus, hipDeviceAttributeMultiprocessorCount, dev) != hipSuccess) { grid = -1; return; }
        if (hipFuncSetAttribute((const void*)fwd, hipFuncAttributeMaxDynamicSharedMemorySize, LDS_BYTES) != hipSuccess) { fprintf(stderr, "kernel_launch: hipFuncSetAttribute failed\n"); grid = -1; return; }
        int per_cu = 0;
        if (hipOccupancyMaxActiveBlocksPerMultiprocessor(&per_cu, (const void*)fwd, NWAVES * 64, LDS_BYTES) != hipSuccess || per_cu < 1) fprintf(stderr, "kernel_launch: occupancy query reports %d\n", per_cu);
        (void)hipGetLastError();
        grid = cus;
    }
    if (grid < 0) return;
    (void)hipMemsetAsync((char*)d_ws + WS_CTL, 0, CTL_ZERO_BYTES, stream);
    Args a{};
    for (int i = 0; i < 23; ++i) a.in[i] = (const float*)d_in[i];
    a.out = (float*)d_out; a.ws = (unsigned char*)d_ws;
#if PROBE_DUP >= 0
    a.ph_lo = 0; a.ph_hi = PROBE_DUP + 1; a.li = 0; hipLaunchKernelGGL(fwd, dim3(grid), dim3(NWAVES * 64), LDS_BYTES, stream, a);
    if (PROBE_DUP == 6) (void)hipMemsetAsync((char*)d_ws + WS_CTL + CW_CNT * 4, 0, 128, stream);
    a.ph_lo = PROBE_DUP; a.ph_hi = PROBE_DUP + 1; a.li = 1; hipLaunchKernelGGL(fwd, dim3(grid), dim3(NWAVES * 64), LDS_BYTES, stream, a);
    if (PROBE_DUP + 1 < 10) { a.ph_lo = PROBE_DUP + 1; a.ph_hi = 10; a.li = 2; hipLaunchKernelGGL(fwd, dim3(grid), dim3(NWAVES * 64), LDS_BYTES, stream, a); }
#else
    a.ph_lo = 0; a.ph_hi = 10; a.li = 0;
    hipLaunchKernelGGL(fwd, dim3(grid), dim3(NWAVES * 64), LDS_BYTES, stream, a);
#endif
}
```

```cpp
#include <hip/hip_runtime.h>
#include <cstdio>
#include <cstdint>
#ifndef PROBE_DUP
#define PROBE_DUP -1
#endif

#define GAS __attribute__((address_space(1)))
#define LAS __attribute__((address_space(3)))
typedef unsigned short bf16;
typedef unsigned v4u __attribute__((ext_vector_type(4)));
typedef unsigned v2u __attribute__((ext_vector_type(2)));
typedef float f32x4 __attribute__((ext_vector_type(4)));
typedef float f32x2 __attribute__((ext_vector_type(2)));
typedef float f32x16 __attribute__((ext_vector_type(16)));
typedef short bf16x8 __attribute__((ext_vector_type(8)));
typedef short s16x4 __attribute__((ext_vector_type(4)));
typedef int v4i __attribute__((ext_vector_type(4)));
typedef GAS unsigned gu32;
#define RLX_AGENT __ATOMIC_RELAXED, __HIP_MEMORY_SCOPE_AGENT
#define LDS_WAIT() asm volatile("s_waitcnt lgkmcnt(0)" ::: "memory")
#define VM_WAIT() asm volatile("s_waitcnt vmcnt(0)" ::: "memory")

constexpr int D = 1024, BATCH = 16, SEQ = 2048, T = BATCH * SEQ;
constexpr int MEMLEN = 256, TM = BATCH * MEMLEN;
constexpr int INW = 7424;
constexpr int C_SQ = 0, C_SK = 512, C_SV = 640, C_RQ = 768, C_RK = 1280, C_RV = 1792, C_RG = 2816, C_MQ = 3840, C_ZG = 4352;
constexpr int NE = 32, TOPK = 4, DFF = 1024;
constexpr int OC = 2048;
constexpr float EPS = 1e-6f;
constexpr int LCAP = T;
constexpr int ACT_ROWS = T * TOPK + NE * 256;

constexpr size_t MiB = 1u << 20;
constexpr size_t WS_CTL = 0, CTL_ZERO_BYTES = 1 * MiB;
constexpr size_t WS_ROPE = 1 * MiB;
constexpr size_t WS_WIN = 2 * MiB;
constexpr size_t WS_WMKV = 17 * MiB;
constexpr size_t WS_WBR = 19 * MiB;
constexpr size_t WS_WOUT = 23 * MiB;
constexpr size_t WS_WR = 25 * MiB;
constexpr size_t WS_WSC = 25 * MiB + 256 * 1024;
constexpr size_t WS_WUP = 26 * MiB;
constexpr size_t WS_WDN = 154 * MiB;
constexpr size_t WS_H = 218 * MiB;
constexpr size_t WS_MB = 282 * MiB;
constexpr size_t WS_MKV = 290 * MiB;
constexpr size_t WS_Z = 298 * MiB;
constexpr size_t WS_OC = 762 * MiB;
constexpr size_t WS_ST = 890 * MiB;
constexpr size_t WS_LIST = 954 * MiB;
constexpr size_t WS_GATE = 958 * MiB;
constexpr size_t WS_LSC = 962 * MiB;
constexpr size_t WS_ACT = 298 * MiB;
constexpr size_t WS_Y = 570 * MiB;
constexpr size_t WS_END = 966 * MiB;
static_assert(WS_ACT + (size_t)ACT_ROWS * 1024 * 2 <= WS_Y && WS_Y + (size_t)T * 4 * 1024 * 2 <= WS_ST + 64 * MiB, "overlay map");
constexpr int CW_TMO = 0, CW_CODE = 1;
constexpr int CW_CNT = 64;
constexpr int CW_BAR = 4096;

constexpr int SCR_BYTES = 147456;
constexpr int MISC_OFF = SCR_BYTES;
constexpr int LDS_BYTES = SCR_BYTES + 1024;

__device__ __forceinline__ unsigned cvt_pk_bf16(float lo, float hi) { unsigned r; asm volatile("v_cvt_pk_bf16_f32 %0, %1, %2" : "=v"(r) : "v"(lo), "v"(hi)); return r; }
__device__ __forceinline__ float bf_lo(unsigned w) { return __builtin_bit_cast(float, w << 16); }
__device__ __forceinline__ float bf_hi(unsigned w) { return __builtin_bit_cast(float, w & 0xffff0000u); }
__device__ __forceinline__ float wave_sum(float v) {
#pragma unroll
    for (int o = 1; o < 64; o <<= 1) v += __shfl_xor(v, o);
    return v;
}
__device__ __forceinline__ float sigmoidf_(float x) { return 1.f / (1.f + __expf(-x)); }

#define XB_TMO      128
#define XB_XCNT(j)  (256  + 64 * (j))
#define XB_XSUB(j)  (1280 + 64 * (j))
#define XB_XGEN(j)  (2304 + 64 * (j))
#define XB_TOP      3328
#define XB_TOPGEN   3392
#define XCD_BAR_WORDS 3456
#define XB_SPIN_CAP (1u << 18)
__device__ __forceinline__ unsigned xb_ld(unsigned* p)              { return __hip_atomic_load(p, __ATOMIC_RELAXED, __HIP_MEMORY_SCOPE_AGENT); }
__device__ __forceinline__ unsigned xb_add(unsigned* p, unsigned v) { return __hip_atomic_fetch_add(p, v, __ATOMIC_RELAXED, __HIP_MEMORY_SCOPE_AGENT); }
__device__ __forceinline__ unsigned xb_xcc_id() { return (unsigned)__builtin_amdgcn_s_getreg((3 << 11) | 20) & 0xFu; }
#define XB_SPIN(cond, bar) do { unsigned _sp = 0; while (cond) { __builtin_amdgcn_s_sleep(1); \
    if ((++_sp & 255u) == 0u) { if (xb_ld(&(bar)[XB_TMO])) break; if (_sp > XB_SPIN_CAP) { atomicAdd(&(bar)[XB_TMO], 1u); break; } } } } while (0)
struct XcdBarrier { unsigned* bar; unsigned x; volatile LAS unsigned* st; };
__device__ __forceinline__ XcdBarrier xcd_barrier_post(unsigned* bar, volatile LAS unsigned* st) {
    XcdBarrier b; b.bar = bar; b.x = xb_xcc_id(); b.st = st;
    if (threadIdx.x == 0) (void)xb_add(&bar[XB_XCNT(b.x)], 1u);
    return b;
}
__device__ __forceinline__ void xcd_barrier_complete(unsigned* bar, unsigned x, unsigned& nloc, unsigned& nx) {
    const unsigned G = gridDim.x * gridDim.y * gridDim.z;
    unsigned sum, cnt, mine, sp = 0u;
    for (;;) {
        sum = 0u; cnt = 0u; mine = 0u;
#pragma unroll
        for (unsigned j = 0; j < 16; ++j) { const unsigned c = xb_ld(&bar[XB_XCNT(j)]); sum += c; cnt += (c > 0u) ? 1u : 0u; mine = (j == x) ? c : mine; }
        if (sum == G) break;
        __builtin_amdgcn_s_sleep(1);
        if ((++sp & 255u) == 0u) { if (xb_ld(&bar[XB_TMO])) break; if (sp > XB_SPIN_CAP) { atomicAdd(&bar[XB_TMO], 1u); break; } }
    }
    nloc = mine > 0u ? mine : 1u; nx = cnt > 0u ? cnt : 1u;
}
__device__ __forceinline__ void xcd_barrier(const XcdBarrier& b) {
    asm volatile("s_waitcnt vmcnt(0)" ::: "memory");
    __syncthreads();
    if (threadIdx.x == 0) {
        unsigned* bar = b.bar;
        __builtin_amdgcn_s_waitcnt(0);
        unsigned nloc = b.st[0], nx = b.st[1];
        if (nloc == 0u) { xcd_barrier_complete(bar, b.x, nloc, nx); b.st[0] = nloc; b.st[1] = nx; }
        const unsigned old = xb_add(&bar[XB_XSUB(b.x)], 1u);
        const unsigned gen = old / nloc;
        if (old + 1u == (gen + 1u) * nloc) {
            __builtin_amdgcn_fence(__ATOMIC_RELEASE, "agent");
            asm volatile("s_waitcnt vmcnt(0)" ::: "memory");
            const unsigned og = xb_add(&bar[XB_TOP], 1u);
            const unsigned tg = og / nx;
            if (og + 1u == (tg + 1u) * nx) xb_add(&bar[XB_TOPGEN], 1u);
            else XB_SPIN(xb_ld(&bar[XB_TOPGEN]) == tg, bar);
            __builtin_amdgcn_fence(__ATOMIC_ACQUIRE, "agent");
            xb_add(&bar[XB_XGEN(b.x)], 1u);
            asm volatile("s_waitcnt vmcnt(0)" ::: "memory");
        } else {
            XB_SPIN(xb_ld(&bar[XB_XGEN(b.x)]) == gen, bar);
            __builtin_amdgcn_fence(__ATOMIC_ACQUIRE, "agent");
            asm volatile("s_waitcnt vmcnt(0)" ::: "memory");
        }
    }
    __syncthreads();
}

namespace pg8 {
constexpr int BM = 256, BK = 64, HALF = 128, HTB = HALF * BK * 2, STAGE_BYTES = 8 * HTB, NXCD = 8, WGM = 8;
__device__ __forceinline__ int lds_byte(int r, int c) { const int st = (r >> 4) * 2 + (c >> 5), rr = r & 15, cc = c & 31, ob = rr * 64 + cc * 2; return st * 1024 + (ob ^ (((ob >> 9) & 1) << 5)); }
__device__ __forceinline__ void stage_rc(int b, int& R, int& C) { const int st = b / 1024, sb = b % 1024, swz = sb ^ (((sb >> 9) & 1) << 5); R = (st >> 1) * 16 + swz / 64; C = (st & 1) * 32 + (swz % 64) / 2; }
__device__ __forceinline__ int perm32(int rho) { const int n = rho >> 4, i = rho & 15; return 8 * (i >> 2) + 4 * n + (i & 3); }
struct Unit { int pm, pn, e, x; };
__device__ __forceinline__ bool static_order(int L, int nM, int nN, int& pm, int& pn) {
    const int nwg = nM * nN; if (L >= nwg) return false;
    int wgid = L; { const int q = nwg / NXCD, r = nwg % NXCD, xcd = wgid % NXCD, off = wgid / NXCD; wgid = (xcd < r ? xcd * (q + 1) : r * (q + 1) + (xcd - r) * q) + off; }
    const int nig = WGM * nN, gid = wgid / nig, fm = gid * WGM, gsz = (nM - fm) < WGM ? (nM - fm) : WGM;
    pm = fm + ((wgid % nig) % gsz); pn = (wgid % nig) / gsz; return true;
}
__device__ __forceinline__ f32x4 mma16(bf16x8 a, bf16x8 b, f32x4 c) { return __builtin_amdgcn_mfma_f32_16x16x32_bf16(a, b, c, 0, 0, 0); }
__device__ __forceinline__ v4i mma16(bf16x8 a, bf16x8 b, v4i c) { return __builtin_amdgcn_mfma_i32_16x16x64_i8(__builtin_bit_cast(v4i, a), __builtin_bit_cast(v4i, b), c, 0, 0, 0); }
template <class P>
__device__ __forceinline__ void gemm_phase(LAS unsigned char* lds, const P& p) {
    typedef typename P::AccT AccT;
    const int tid = threadIdx.x, wid = __builtin_amdgcn_readfirstlane(tid >> 6), lane = tid & 63, wr = wid >> 2, wc = wid & 3, fr = lane & 15, fq = lane >> 4;
    const int K = p.K, nt = K / BK;
    unsigned voffB[2], vA[2][2], vN[2][2];
    const size_t kstep = (size_t)(BK * 2);
    const size_t hstep = (size_t)HALF * K * 2;
#pragma unroll
    for (int i = 0; i < 2; ++i) { int R, C; stage_rc(tid * 16 + i * 8192, R, C); const int Rb = P::PERM ? ((R & ~31) + perm32(R & 31)) : R;
        voffB[i] = (unsigned)(Rb * K + C) * 2u; vA[0][i] = (unsigned)(R * K + C) * 2u; vA[1][i] = vA[0][i] + (unsigned)hstep; }
    const unsigned ldsw = (unsigned)wid * 1024u;
    const int aoff = lds_byte(wr * 64 + fr, fq * 8), boff = lds_byte(wc * 32 + fr, fq * 8);
#define PG8_SA(b, h) (((b) * 2 + (h)) * HTB)
#define PG8_SB(b, h) ((4 + (b) * 2 + (h)) * HTB)
#define PG8_STAGE(bufoff, gbase, voff) do { _Pragma("unroll") for (int _i = 0; _i < 2; ++_i) \
        __builtin_amdgcn_global_load_lds((const unsigned*)((const char*)(gbase) + (voff)[_i]), (LAS unsigned*)(lds + (bufoff) + ldsw + _i * 8192), 16, 0, 0); } while (0)
#define PG8_LDA(dst, b, h) do { _Pragma("unroll") for (int m = 0; m < 4; ++m) _Pragma("unroll") for (int k = 0; k < 2; ++k) dst[m][k] = *(const LAS bf16x8*)(lds + PG8_SA(b, h) + aoff + m * 2048 + k * 1024); } while (0)
#define PG8_LDB(dst, b, h) do { _Pragma("unroll") for (int n = 0; n < 2; ++n) _Pragma("unroll") for (int k = 0; k < 2; ++k) dst[n][k] = *(const LAS bf16x8*)(lds + PG8_SB(b, h) + boff + n * 2048 + k * 1024); } while (0)
#define PG8_MMA(ai, bj, At, Bt) do { __builtin_amdgcn_s_setprio(1); _Pragma("unroll") for (int m = 0; m < 4; ++m) _Pragma("unroll") for (int n = 0; n < 2; ++n) _Pragma("unroll") for (int k = 0; k < 2; ++k) \
        acc[ai][bj][m][n] = mma16(Bt[n][k], At[m][k], acc[ai][bj][m][n]); __builtin_amdgcn_s_setprio(0); } while (0)
#define PG8_WAIT_V(n) asm volatile("s_waitcnt vmcnt(" #n ")" ::: "memory")
#define PG8_WAIT_L(n) asm volatile("s_waitcnt lgkmcnt(" #n ")" ::: "memory")
#define PG8_BAR __builtin_amdgcn_s_barrier()
#define PG8_SCHED __builtin_amdgcn_sched_barrier(0)
    Unit cur, nxt; int ui = 0;
    if (!p.next(0, cur)) return;
    AccT acc[2][2][4][2];
#pragma unroll
    for (int a = 0; a < 2; ++a)
#pragma unroll
        for (int b = 0; b < 2; ++b)
#pragma unroll
            for (int m = 0; m < 4; ++m)
#pragma unroll
                for (int n = 0; n < 2; ++n) acc[a][b][m][n] = (AccT){0, 0, 0, 0};
    bf16x8 At[4][2], B0[2][2], B1[2][2];
    const char* cA = p.a_base(cur); const char* cB = p.b_base(cur);
    if constexpr (P::GATHER) { p.a_off(cur, tid, vA); asm volatile("" : "+v"(vA[0][0]), "+v"(vA[0][1]), "+v"(vA[1][0]), "+v"(vA[1][1])); }
    PG8_STAGE(PG8_SB(0, 0), cB, voffB); PG8_STAGE(PG8_SB(0, 1), cB + hstep, voffB); PG8_STAGE(PG8_SA(0, 0), cA, vA[0]); PG8_STAGE(PG8_SA(0, 1), cA, vA[1]);
    if (wr == 1) PG8_BAR;
    PG8_WAIT_V(2); PG8_BAR;
    PG8_STAGE(PG8_SB(1, 0), cB + kstep, voffB); PG8_STAGE(PG8_SA(1, 0), cA + kstep, vA[0]); PG8_STAGE(PG8_SB(1, 1), cB + hstep + kstep, voffB);
    PG8_WAIT_V(6); PG8_BAR;
    for (;;) {
        const bool has_next = p.next(ui + 1, nxt);
        const char* nA = has_next ? p.a_base(nxt) : cA; const char* nB = has_next ? p.b_base(nxt) : cB;
        if constexpr (P::GATHER) {
            if (has_next) p.a_off(nxt, tid, vN); else { vN[0][0] = vA[0][0]; vN[0][1] = vA[0][1]; vN[1][0] = vA[1][0]; vN[1][1] = vA[1][1]; }
            asm volatile("" : "+v"(vN[0][0]), "+v"(vN[0][1]), "+v"(vN[1][0]), "+v"(vN[1][1]));
        }
        for (int t = 0; t < nt; t += 2) {
            const bool last = (t == nt - 2);
            if constexpr (P::HAS_MID) p.mid(acc, cur, t, wr, wc, fr, fq);
            const char* a1 = cA + (size_t)(t + 1) * kstep;
            const char* a2 = last ? nA : cA + (size_t)(t + 2) * kstep; const char* b2 = last ? nB : cB + (size_t)(t + 2) * kstep;
            const char* a3 = a2 + kstep; const char* b3 = b2 + kstep;
            unsigned o0[2], o1[2];
            if constexpr (P::GATHER) { o0[0] = last ? vN[0][0] : vA[0][0]; o0[1] = last ? vN[0][1] : vA[0][1]; o1[0] = last ? vN[1][0] : vA[1][0]; o1[1] = last ? vN[1][1] : vA[1][1]; }
            else { o0[0] = vA[0][0]; o0[1] = vA[0][1]; o1[0] = vA[1][0]; o1[1] = vA[1][1]; }
            PG8_LDB(B0, 0, 0); PG8_LDB(B1, 0, 1); PG8_SCHED; PG8_LDA(At, 0, 0); PG8_STAGE(PG8_SA(1, 1), a1, vA[1]);
            PG8_WAIT_V(8); PG8_WAIT_L(0); PG8_BAR; PG8_MMA(0, 0, At, B0); PG8_MMA(0, 1, At, B1); PG8_BAR; PG8_SCHED;
            PG8_LDA(At, 0, 1); PG8_STAGE(PG8_SB(0, 0), b2, voffB); PG8_STAGE(PG8_SB(0, 1), b2 + hstep, voffB); PG8_STAGE(PG8_SA(0, 0), a2, o0);
            PG8_WAIT_V(8); PG8_WAIT_L(0); PG8_BAR; PG8_MMA(1, 0, At, B0); PG8_MMA(1, 1, At, B1); PG8_BAR; PG8_SCHED;
            PG8_LDB(B0, 1, 0); PG8_LDB(B1, 1, 1); PG8_SCHED; PG8_LDA(At, 1, 0); PG8_STAGE(PG8_SA(0, 1), a2, o1);
            PG8_WAIT_V(8); PG8_WAIT_L(0); PG8_BAR; PG8_MMA(0, 0, At, B0); PG8_MMA(0, 1, At, B1); PG8_BAR; PG8_SCHED;
            PG8_LDA(At, 1, 1); PG8_STAGE(PG8_SB(1, 0), b3, voffB); PG8_STAGE(PG8_SB(1, 1), b3 + hstep, voffB); PG8_STAGE(PG8_SA(1, 0), a3, o0);
            PG8_WAIT_V(8); PG8_WAIT_L(0); PG8_BAR; PG8_MMA(1, 0, At, B0); PG8_MMA(1, 1, At, B1); PG8_BAR; PG8_SCHED;
        }
        if (wr == 0) PG8_BAR;
        p.epi(acc, cur, wr, wc, fr, fq);
        if (!has_next) break;
#pragma unroll
        for (int a = 0; a < 2; ++a)
#pragma unroll
            for (int b = 0; b < 2; ++b)
#pragma unroll
                for (int m = 0; m < 4; ++m)
#pragma unroll
                    for (int n = 0; n < 2; ++n) acc[a][b][m][n] = (AccT){0, 0, 0, 0};
        cur = nxt; cA = nA; cB = nB; ++ui;
        if constexpr (P::GATHER) { vA[0][0] = vN[0][0]; vA[0][1] = vN[0][1]; vA[1][0] = vN[1][0]; vA[1][1] = vN[1][1]; }
        if (wr == 1) PG8_BAR;
    }
    PG8_WAIT_V(0);
    PG8_BAR;
#undef PG8_SA
#undef PG8_SB
#undef PG8_STAGE
#undef PG8_LDA
#undef PG8_LDB
#undef PG8_MMA
#undef PG8_WAIT_V
#undef PG8_WAIT_L
#undef PG8_BAR
#undef PG8_SCHED
}
}
using pg8::Unit;

constexpr int NWAVES = 8;
struct Frame {
    LAS unsigned char* lds;
    volatile LAS unsigned* MISC;
    gu32* ctl;
    int tid, lane, wave;
    int G, bid;
    unsigned char* ws;
};
struct Args { const float* in[23]; float* out; unsigned char* ws; int ph_lo, ph_hi, li, pad; };

template <class RowMap>
__device__ __forceinline__ void p0_transpose_item(const float* W, int K, int N, bf16* WT, int ldt, int k_off, LAS float* scr, int item, int lane, const RowMap& rm) {
    const int nblk = N / 32, kb = item / nblk, nb = item % nblk, k0 = 64 * kb, n0 = 32 * nb;
    float tv[32];
#pragma unroll
    for (int i = 0; i < 32; ++i) { const int kk = 2 * i + (lane >> 5); tv[i] = W[(size_t)(k0 + kk) * N + n0 + (lane & 31)]; }
#pragma unroll
    for (int i = 0; i < 32; ++i) { const int kk = 2 * i + (lane >> 5); scr[kk * 33 + (lane & 31)] = tv[i]; }
    LDS_WAIT(); asm volatile("" ::: "memory");
    const int c = lane & 7;
#pragma unroll
    for (int j = 0; j < 4; ++j) { const int n = (lane >> 3) + 8 * j; const LAS float* s = scr + (8 * c) * 33 + n;
        v4u o; o.x = cvt_pk_bf16(s[0 * 33], s[1 * 33]); o.y = cvt_pk_bf16(s[2 * 33], s[3 * 33]); o.z = cvt_pk_bf16(s[4 * 33], s[5 * 33]); o.w = cvt_pk_bf16(s[6 * 33], s[7 * 33]);
        *(GAS v4u*)(WT + (size_t)rm(n0 + n) * ldt + k_off + k0 + 8 * c) = o; }
    LDS_WAIT(); asm volatile("" ::: "memory");
}
struct RmId { __device__ __forceinline__ int operator()(int n) const { return n; } };
struct RmUp { __device__ __forceinline__ int operator()(int n) const { const int j = n >> 1, s = n & 1; return 256 * (j >> 7) + 128 * s + (j & 127); } };
__device__ __forceinline__ void p0_quant_up_item(const float* W, signed char* WQ, float* wsc, LAS float* scr, int nb, int lane) {
    const int n0 = 32 * nb; const RmUp rm; const float* wc = W + n0 + (lane & 31);
    float mx = 0.f;
#pragma unroll 1
    for (int kb = 0; kb < 16; ++kb) { float tv[32];
#pragma unroll
        for (int i = 0; i < 32; ++i) { const int kk = 64 * kb + 2 * i + (lane >> 5); tv[i] = wc[(size_t)kk * 2048]; }
#pragma unroll
        for (int i = 0; i < 32; ++i) mx = fmaxf(mx, fabsf(tv[i])); }
    mx = fmaxf(mx, __shfl_xor(mx, 32));
    const float inv = mx > 0.f ? 127.f / mx : 0.f;
    if (lane < 32) wsc[rm(n0 + lane)] = mx * (1.f / 127.f);
    const int n = lane >> 1, half = lane & 1;
    signed char* orow = WQ + (size_t)rm(n0 + n) * 1024 + 32 * half;
#pragma unroll 1
    for (int kb = 0; kb < 16; ++kb) {
        float tv[32];
#pragma unroll
        for (int i = 0; i < 32; ++i) { const int kk = 2 * i + (lane >> 5); tv[i] = wc[(size_t)(64 * kb + kk) * 2048]; }
#pragma unroll
        for (int i = 0; i < 32; ++i) { const int kk = 2 * i + (lane >> 5); scr[kk * 33 + (lane & 31)] = tv[i] * inv; }
        LDS_WAIT(); asm volatile("" ::: "memory");
        unsigned wq[8];
#pragma unroll
        for (int d = 0; d < 8; ++d) { unsigned w = 0;
#pragma unroll
            for (int j = 0; j < 4; ++j) { const int q = (int)rintf(scr[(32 * half + 4 * d + j) * 33 + n]); w |= ((unsigned)q & 0xffu) << (8 * j); }
            wq[d] = w; }
        *(GAS v4u*)(orow + 64 * kb) = (v4u){wq[0], wq[1], wq[2], wq[3]}; *(GAS v4u*)(orow + 64 * kb + 16) = (v4u){wq[4], wq[5], wq[6], wq[7]};
        LDS_WAIT(); asm volatile("" ::: "memory");
    }
}
__device__ __forceinline__ void rms_row_to_bf16(const float* xrow, const float* gain, bf16* orow, int lane) {
    const GAS f32x4* xr = (const GAS f32x4*)xrow + lane; const GAS f32x4* gr = (const GAS f32x4*)gain + lane;
    f32x4 v[4]; float s = 0.f;
#pragma unroll
    for (int j = 0; j < 4; ++j) { v[j] = xr[64 * j]; s += (v[j].x * v[j].x + v[j].y * v[j].y) + (v[j].z * v[j].z + v[j].w * v[j].w); }
    const float rstd = 1.f / sqrtf(wave_sum(s) * (1.f / D) + EPS);
    GAS v2u* o8 = (GAS v2u*)orow + lane;
#pragma unroll
    for (int j = 0; j < 4; ++j) { const f32x4 g = gr[64 * j]; v2u o; o.x = cvt_pk_bf16(v[j].x * rstd * g.x, v[j].y * rstd * g.y); o.y = cvt_pk_bf16(v[j].z * rstd * g.z, v[j].w * rstd * g.w); o8[64 * j] = o; }
}
__device__ __forceinline__ void p0_prologue(Frame& F, const Args& a) {
    LAS float* scr = (LAS float*)(F.lds + F.wave * 16384);
    const int gw = F.bid * NWAVES + F.wave, NGW = F.G * NWAVES;
    bf16* Win_t = (bf16*)(F.ws + WS_WIN); bf16* Wmkv_t = (bf16*)(F.ws + WS_WMKV); bf16* Wbr_t = (bf16*)(F.ws + WS_WBR); bf16* Wout_t = (bf16*)(F.ws + WS_WOUT);
    signed char* Wup_q = (signed char*)(F.ws + WS_WUP); float* Wsc = (float*)(F.ws + WS_WSC); bf16* Wdn_t = (bf16*)(F.ws + WS_WDN);
    constexpr int I_IN = (D / 64) * (INW / 32), I_MKV = 16 * 32, I_BS = 8 * 32, I_BR = 16 * 32, I_BM = 8 * 32, I_OUT = 16 * 32, I_UP1 = 64, I_DN1 = 16 * 32;
    constexpr int I_UP = NE * I_UP1, I_DN = NE * I_DN1;
    constexpr int NITEMS = I_IN + I_MKV + I_BS + I_BR + I_BM + I_OUT + I_UP + I_DN;
    for (int it = gw; it < NITEMS; it += NGW) {
        int r = it;
        if (r < I_IN) { p0_transpose_item(a.in[4], D, INW, Win_t, D, 0, scr, r, F.lane, RmId()); continue; } r -= I_IN;
        if (r < I_MKV) { p0_transpose_item(a.in[9], D, 1024, Wmkv_t, D, 0, scr, r, F.lane, RmId()); continue; } r -= I_MKV;
        if (r < I_BS) { p0_transpose_item(a.in[12], 512, D, Wbr_t, 2048, 0, scr, r, F.lane, RmId()); continue; } r -= I_BS;
        if (r < I_BR) { p0_transpose_item(a.in[13], 1024, D, Wbr_t, 2048, 512, scr, r, F.lane, RmId()); continue; } r -= I_BR;
        if (r < I_BM) { p0_transpose_item(a.in[14], 512, D, Wbr_t, 2048, 1536, scr, r, F.lane, RmId()); continue; } r -= I_BM;
        if (r < I_OUT) { p0_transpose_item(a.in[15], D, D, Wout_t, D, 0, scr, r, F.lane, RmId()); continue; } r -= I_OUT;
        if (r < I_UP) { const int e = r / I_UP1; p0_quant_up_item(a.in[19] + (size_t)e * D * 2048, Wup_q + (size_t)e * 2048 * D, Wsc + (size_t)e * 2048, scr, r % I_UP1, F.lane); continue; } r -= I_UP;
        { const int e = r / I_DN1; p0_transpose_item(a.in[21] + (size_t)e * DFF * D, DFF, D, Wdn_t + (size_t)e * D * DFF, DFF, 0, scr, r % I_DN1, F.lane, RmId()); }
    }
    bf16* H = (bf16*)(F.ws + WS_H); bf16* MB = (bf16*)(F.ws + WS_MB);
    for (int m = gw; m < T; m += NGW) rms_row_to_bf16(a.in[0] + (size_t)m * D, a.in[2], H + (size_t)m * D, F.lane);
    for (int m = gw; m < TM; m += NGW) rms_row_to_bf16(a.in[1] + (size_t)m * D, a.in[3], MB + (size_t)m * D, F.lane);
    float* rc = (float*)(F.ws + WS_ROPE); float* rs = rc + SEQ * 64;
    for (int i = F.bid * 512 + F.tid; i < SEQ * 64; i += F.G * 512) { const int s = i >> 6, j = i & 63;
        const double inv = exp2(-(double)j * (13.287712379549449 / 64.0));
        const double rev = (double)s * inv * 0.15915494309189535; const float fr = (float)(rev - floor(rev));
        rc[i] = __builtin_amdgcn_cosf(fr); rs[i] = __builtin_amdgcn_sinf(fr); }
    float* wrt = (float*)(F.ws + WS_WR);
    for (int i = F.bid * 512 + F.tid; i < NE * D; i += F.G * 512) { const int e = i >> 10, k = i & 1023; wrt[i] = a.in[17][(size_t)k * NE + e]; }
}

__device__ __forceinline__ void epi_store_bf16(const f32x4 (&acc)[2][2][4][2], bf16* base, int ldc, int wr, int wc, int fr, int fq) {
    bf16* b0 = base + (size_t)(wr * 64 + fr) * ldc + wc * 32 + 8 * fq;
#pragma unroll
    for (int ai = 0; ai < 2; ++ai)
#pragma unroll
        for (int m = 0; m < 4; ++m) { bf16* rowp = b0 + (size_t)(ai * 128 + m * 16) * ldc;
#pragma unroll
            for (int bj = 0; bj < 2; ++bj) { const f32x4 v0 = acc[ai][bj][m][0], v1 = acc[ai][bj][m][1];
                v4u w; w.x = cvt_pk_bf16(v0[0], v0[1]); w.y = cvt_pk_bf16(v0[2], v0[3]); w.z = cvt_pk_bf16(v1[0], v1[1]); w.w = cvt_pk_bf16(v1[2], v1[3]);
                *(v4u*)(rowp + bj * 128) = w; } }
}
struct P1Policy {
    typedef f32x4 AccT;
    static constexpr bool PERM = true, GATHER = false, HAS_MID = false;
    int K, G, c; const bf16 *H, *MB, *Win, *Wmkv; bf16 *Z, *MKV;
    static constexpr int NM1 = T / 256, NN1 = INW / 256, NU1 = NM1 * NN1, NU2 = (TM / 256) * 4;
    __device__ __forceinline__ bool next(int i, Unit& u) const {
        const int L = i * G + c;
        if (L < NU1) { u.e = 0; return pg8::static_order(L, NM1, NN1, u.pm, u.pn); }
        const int L2 = L - NU1; if (L2 >= NU2) return false;
        u.e = 1; u.pm = L2 >> 2; u.pn = L2 & 3; return true;
    }
    __device__ __forceinline__ const char* a_base(const Unit& u) const { return (const char*)(u.e ? MB : H) + (size_t)u.pm * 256 * D * 2; }
    __device__ __forceinline__ const char* b_base(const Unit& u) const { return (const char*)(u.e ? Wmkv : Win) + (size_t)u.pn * 256 * D * 2; }
    __device__ __forceinline__ void a_off(const Unit&, int, unsigned (&)[2][2]) const {}
    __device__ __forceinline__ void mid(f32x4 (&)[2][2][4][2], const Unit&, int, int, int, int, int) const {}
    __device__ __forceinline__ void epi(const f32x4 (&acc)[2][2][4][2], const Unit& u, int wr, int wc, int fr, int fq) const {
        if (u.e) epi_store_bf16(acc, MKV + (size_t)u.pm * 256 * 1024 + u.pn * 256, 1024, wr, wc, fr, fq);
        else epi_store_bf16(acc, Z + (size_t)u.pm * 256 * INW + u.pn * 256, INW, wr, wc, fr, fq);
    }
};


__device__ __forceinline__ int crow(int r, int hi) { return (r & 3) + 8 * (r >> 2) + 4 * hi; }
#define MFMA32(a, b, c) __builtin_amdgcn_mfma_f32_32x32x16_bf16((a), (b), (c), 0, 0, 0)
__device__ __forceinline__ float ret_log2g(int h) { return h == 0 ? -0.04580368961312479f : (h == 1 ? -0.02272007650008353f : (h == 2 ? -0.011315313227834146f : -0.005646563141142062f)); }
__device__ __forceinline__ void unpack8(const v4u w, float (&f)[8]) { f[0] = bf_lo(w.x); f[1] = bf_hi(w.x); f[2] = bf_lo(w.y); f[3] = bf_hi(w.y); f[4] = bf_lo(w.z); f[5] = bf_hi(w.z); f[6] = bf_lo(w.w); f[7] = bf_hi(w.w); }
__device__ __forceinline__ v4u pack8(const float (&f)[8]) { v4u w; w.x = cvt_pk_bf16(f[0], f[1]); w.y = cvt_pk_bf16(f[2], f[3]); w.z = cvt_pk_bf16(f[4], f[5]); w.w = cvt_pk_bf16(f[6], f[7]); return w; }
__device__ __forceinline__ bf16x8 as_bf16x8(v4u w) { return __builtin_bit_cast(bf16x8, w); }
__device__ __forceinline__ void st16(LAS unsigned char* p, unsigned short v) { *(LAS unsigned short*)p = v; }

__device__ __forceinline__ void rot16(const v4u la, const v4u lb, const v4u ha, const v4u hb, const float* cs, const float* sn, float scale, float (&o1)[16], float (&o2)[16]) {
    float t1[16], t2[16];
    { float f[8]; unpack8(la, f);
#pragma unroll
      for (int e = 0; e < 8; ++e) t1[e] = f[e]; unpack8(lb, f);
#pragma unroll
      for (int e = 0; e < 8; ++e) t1[8 + e] = f[e]; unpack8(ha, f);
#pragma unroll
      for (int e = 0; e < 8; ++e) t2[e] = f[e]; unpack8(hb, f);
#pragma unroll
      for (int e = 0; e < 8; ++e) t2[8 + e] = f[e]; }
#pragma unroll
    for (int q = 0; q < 4; ++q) { const f32x4 c4 = *(const GAS f32x4*)(cs + 4 * q), s4 = *(const GAS f32x4*)(sn + 4 * q);
#pragma unroll
        for (int e = 0; e < 4; ++e) { const float a = t1[4 * q + e], b = t2[4 * q + e]; o1[4 * q + e] = (a * c4[e] - b * s4[e]) * scale; o2[4 * q + e] = (a * s4[e] + b * c4[e]) * scale; } }
}

__device__ __forceinline__ void ret_scan_unit(Frame& F, int unit) {
    const int b = unit >> 4, h = (unit >> 2) & 3, dq = unit & 3;
    const bf16* Z = (const bf16*)(F.ws + WS_Z);
    const float* rc = (const float*)(F.ws + WS_ROPE); const float* rs = rc + SEQ * 64;
    bf16* ST = (bf16*)(F.ws + WS_ST) + (size_t)((b * 4 + h) * 16) * 256 * 128;
    const float l2g = ret_log2g(h), cd = exp2f(128.f * l2g);
    const int m = F.tid >> 2, cg = F.tid & 3;
    const int dvt = F.wave >> 2, dkt = F.wave & 3, r = F.lane & 31, hh = F.lane >> 5;
    LAS unsigned char* Kt = F.lds; LAS unsigned char* Vt = F.lds + 34816;
    f32x16 acc;
#pragma unroll
    for (int i = 0; i < 16; ++i) acc[i] = 0.f;
    const float kd = 0.08838834764831845f * exp2f((float)(127 - m) * l2g);
    for (int c = 0; c < 16; ++c) {
        { bf16* dst = ST + (size_t)c * 256 * 128 + (size_t)(dq * 64 + dvt * 32) * 128 + dkt * 32 + r;
#pragma unroll
          for (int i = 0; i < 16; ++i) dst[crow(i, hh) * 128] = (bf16)(cvt_pk_bf16(acc[i], 0.f) & 0xffffu); }
        if (c == 15) break;
        const size_t row = (size_t)(b * SEQ + c * 128 + m);
        const bf16* kp = Z + row * INW + C_RK + h * 128 + cg * 16;
        const v4u k1a = *(const GAS v4u*)kp, k1b = *(const GAS v4u*)(kp + 8), k2a = *(const GAS v4u*)(kp + 64), k2b = *(const GAS v4u*)(kp + 72);
        const bf16* vp = Z + row * INW + C_RV + h * 256 + dq * 64 + cg * 16;
        const v4u va = *(const GAS v4u*)vp, vb = *(const GAS v4u*)(vp + 8);
        float o1[16], o2[16];
        rot16(k1a, k1b, k2a, k2b, rc + (size_t)(c * 128 + m) * 64 + cg * 16, rs + (size_t)(c * 128 + m) * 64 + cg * 16, kd, o1, o2);
        __syncthreads();
#pragma unroll
        for (int e = 0; e < 16; e += 2) { const unsigned w1 = cvt_pk_bf16(o1[e], o1[e + 1]), w2 = cvt_pk_bf16(o2[e], o2[e + 1]);
            st16(Kt + (cg * 16 + e) * 272 + m * 2, (unsigned short)w1); st16(Kt + (cg * 16 + e + 1) * 272 + m * 2, (unsigned short)(w1 >> 16));
            st16(Kt + (64 + cg * 16 + e) * 272 + m * 2, (unsigned short)w2); st16(Kt + (64 + cg * 16 + e + 1) * 272 + m * 2, (unsigned short)(w2 >> 16)); }
        { const unsigned vw[8] = {va.x, va.y, va.z, va.w, vb.x, vb.y, vb.z, vb.w};
#pragma unroll
          for (int e = 0; e < 8; ++e) { st16(Vt + (cg * 16 + 2 * e) * 272 + m * 2, (unsigned short)vw[e]); st16(Vt + (cg * 16 + 2 * e + 1) * 272 + m * 2, (unsigned short)(vw[e] >> 16)); } }
        __syncthreads();
#pragma unroll
        for (int i = 0; i < 16; ++i) acc[i] *= cd;
#pragma unroll
        for (int ks = 0; ks < 8; ++ks) { const bf16x8 af = *(const LAS bf16x8*)(Vt + (dvt * 32 + r) * 272 + (ks * 16 + 8 * hh) * 2), bfr = *(const LAS bf16x8*)(Kt + (dkt * 32 + r) * 272 + (ks * 16 + 8 * hh) * 2);
            acc = MFMA32(af, bfr, acc); }
    }
    __syncthreads();
}

__device__ __forceinline__ void swa_unit(Frame& F, const Args& a, int unit) {
    const int b = unit >> 6, hk = (unit >> 5) & 1, qh = unit & 31, p0 = qh * 64;
    const bf16* Z = (const bf16*)(F.ws + WS_Z); bf16* OCb = (bf16*)(F.ws + WS_OC);
    LAS unsigned char* Kl = F.lds; LAS unsigned char* Vt = F.lds + 27648; LAS unsigned char* Ost = F.lds + 53248 + F.wave * 4608;
    const float* qw = a.in[5]; const float* kw = a.in[6];
#pragma unroll
    for (int i = 0; i < 3; ++i) { const int ci = F.tid + 512 * i, row = ci >> 3, ch = ci & 7, kp = p0 - 128 + row;
        v4u kq = (v4u){0u, 0u, 0u, 0u}, vq = (v4u){0u, 0u, 0u, 0u};
        if (kp >= 0) { const bf16* base = Z + (size_t)(b * SEQ + kp) * INW; kq = *(const GAS v4u*)(base + C_SK + hk * 64 + ch * 8); vq = *(const GAS v4u*)(base + C_SV + hk * 64 + ch * 8); }
        float f[8]; unpack8(kq, f); float ss = 0.f;
#pragma unroll
        for (int e = 0; e < 8; ++e) ss += f[e] * f[e];
        ss += __shfl_xor(ss, 1); ss += __shfl_xor(ss, 2); ss += __shfl_xor(ss, 4);
        const float rstd = 1.f / sqrtf(ss * (1.f / 64.f) + EPS);
        const f32x4 w0 = *(const GAS f32x4*)(kw + ch * 8), w1 = *(const GAS f32x4*)(kw + ch * 8 + 4);
#pragma unroll
        for (int e = 0; e < 4; ++e) { f[e] *= rstd * w0[e]; f[4 + e] *= rstd * w1[e]; }
        *(LAS v4u*)(Kl + row * 144 + ch * 16) = pack8(f);
        const unsigned vw[4] = {vq.x, vq.y, vq.z, vq.w};
#pragma unroll
        for (int e = 0; e < 4; ++e) { st16(Vt + (ch * 8 + 2 * e) * 400 + row * 2, (unsigned short)vw[e]); st16(Vt + (ch * 8 + 2 * e + 1) * 400 + row * 2, (unsigned short)(vw[e] >> 16)); } }
    const int g = F.wave >> 1, half = F.wave & 1, r = F.lane & 31, hh = F.lane >> 5;
    const int hq = hk * 4 + g, qi = 32 * half + r;
    bf16x8 qf[4];
    { const bf16* qb = Z + (size_t)(b * SEQ + p0 + qi) * INW + C_SQ + hq * 64 + 8 * hh;
      v4u raw[4]; float ss = 0.f;
#pragma unroll
      for (int ks = 0; ks < 4; ++ks) { raw[ks] = *(const GAS v4u*)(qb + ks * 16); float f[8]; unpack8(raw[ks], f);
#pragma unroll
          for (int e = 0; e < 8; ++e) ss += f[e] * f[e]; }
      ss += __shfl_xor(ss, 32);
      const float rstd = 0.125f / sqrtf(ss * (1.f / 64.f) + EPS);
#pragma unroll
      for (int ks = 0; ks < 4; ++ks) { float f[8]; unpack8(raw[ks], f); const f32x4 w0 = *(const GAS f32x4*)(qw + ks * 16 + 8 * hh), w1 = *(const GAS f32x4*)(qw + ks * 16 + 8 * hh + 4);
#pragma unroll
          for (int e = 0; e < 4; ++e) { f[e] *= rstd * w0[e]; f[4 + e] *= rstd * w1[e]; }
          qf[ks] = as_bf16x8(pack8(f)); } }
    __syncthreads();
    f32x16 s[6];
#pragma unroll
    for (int kb = 0; kb < 6; ++kb) {
#pragma unroll
        for (int i = 0; i < 16; ++i) s[kb][i] = 0.f;
#pragma unroll
        for (int ks = 0; ks < 4; ++ks) { const bf16x8 af = *(const LAS bf16x8*)(Kl + (32 * kb + r) * 144 + (ks * 16 + 8 * hh) * 2); s[kb] = MFMA32(af, qf[ks], s[kb]); } }
    const float sink = a.in[7][hq];
    float mx = sink;
#pragma unroll
    for (int kb = 0; kb < 6; ++kb)
#pragma unroll
        for (int i = 0; i < 16; ++i) { const int kj = 32 * kb + crow(i, hh); const bool valid = (kj > qi) && (kj <= qi + 128) && (p0 - 128 + kj >= 0);
            s[kb][i] = valid ? s[kb][i] : -1e30f; mx = fmaxf(mx, s[kb][i]); }
    mx = fmaxf(mx, __shfl_xor(mx, 32));
    float l = 0.f;
#pragma unroll
    for (int kb = 0; kb < 6; ++kb)
#pragma unroll
        for (int i = 0; i < 16; ++i) { const float pv = __expf(s[kb][i] - mx); s[kb][i] = pv; l += pv; }
    l += __shfl_xor(l, 32); l += __expf(sink - mx);
    f32x16 o[2];
#pragma unroll
    for (int dt = 0; dt < 2; ++dt)
#pragma unroll
        for (int i = 0; i < 16; ++i) o[dt][i] = 0.f;
#pragma unroll
    for (int kb = 0; kb < 6; ++kb)
#pragma unroll
        for (int s2 = 0; s2 < 2; ++s2) { v4u pw; pw.x = cvt_pk_bf16(s[kb][8 * s2 + 0], s[kb][8 * s2 + 1]); pw.y = cvt_pk_bf16(s[kb][8 * s2 + 2], s[kb][8 * s2 + 3]); pw.z = cvt_pk_bf16(s[kb][8 * s2 + 4], s[kb][8 * s2 + 5]); pw.w = cvt_pk_bf16(s[kb][8 * s2 + 6], s[kb][8 * s2 + 7]);
            const bf16x8 pf = as_bf16x8(pw);
#pragma unroll
            for (int dt = 0; dt < 2; ++dt) { const v2u lo = *(const LAS v2u*)(Vt + (32 * dt + r) * 400 + (32 * kb + 16 * s2 + 4 * hh) * 2), hi = *(const LAS v2u*)(Vt + (32 * dt + r) * 400 + (32 * kb + 16 * s2 + 8 + 4 * hh) * 2);
                o[dt] = MFMA32(as_bf16x8((v4u){lo.x, lo.y, hi.x, hi.y}), pf, o[dt]); } }
    const float inv = 1.f / l;
#pragma unroll
    for (int dt = 0; dt < 2; ++dt)
#pragma unroll
        for (int gq = 0; gq < 4; ++gq) { v2u w; w.x = cvt_pk_bf16(o[dt][4 * gq] * inv, o[dt][4 * gq + 1] * inv); w.y = cvt_pk_bf16(o[dt][4 * gq + 2] * inv, o[dt][4 * gq + 3] * inv);
            *(LAS v2u*)(Ost + r * 144 + (32 * dt + 8 * gq + 4 * hh) * 2) = w; }
    LDS_WAIT(); __builtin_amdgcn_wave_barrier();
#pragma unroll
    for (int i = 0; i < 4; ++i) { const int q = F.lane + 64 * i, row = q >> 3, ch = q & 7; const v4u v = *(const LAS v4u*)(Ost + row * 144 + ch * 16);
        *(GAS v4u*)(OCb + (size_t)(b * SEQ + p0 + 32 * half + row) * OC + hq * 64 + ch * 8) = v; }
    __syncthreads();
}

namespace ma {
constexpr int KVBLK = 64, LDQ = INW, LDK = 1024, LDO = OC;
constexpr float SCALE = 0.088388347648318440f, THR = 8.f;
constexpr int SHM_V = KVBLK * 128 * 2, SHM_K = KVBLK * 128 * 2;
#define MA_KSWZ(row, colB) ((row) * 256 + ((colB) ^ (((row) & 7) << 4)))
#define MA_SBAR() __builtin_amdgcn_sched_barrier(0)
__device__ __forceinline__ void partialSM(f32x16& p0, f32x16& p1, float& m_reg, float& mn, float& alpha) {
    constexpr float C = SCALE * 1.4426950408889634f;
    float pmax = p0[0];
#pragma unroll
    for (int r = 1; r < 16; ++r) pmax = fmaxf(pmax, p0[r]);
#pragma unroll
    for (int r = 0; r < 16; ++r) pmax = fmaxf(pmax, p1[r]);
    pmax = fmaxf(pmax, __shfl_xor(pmax, 32));
    if (__builtin_expect(__all(pmax - m_reg <= THR / SCALE), 1)) { mn = m_reg; alpha = 1.f; }
    else { mn = fmaxf(m_reg, pmax); alpha = __builtin_amdgcn_exp2f((m_reg - mn) * C); m_reg = mn; }
    const float mnC = -mn * C;
#pragma unroll
    for (int r = 0; r < 16; ++r) p0[r] = fmaf(p0[r], C, mnC);
#pragma unroll
    for (int r = 0; r < 16; ++r) p1[r] = fmaf(p1[r], C, mnC);
#pragma unroll
    for (int r = 0; r < 16; ++r) p0[r] = __builtin_amdgcn_exp2f(p0[r]);
}
__device__ __forceinline__ void finishSM(f32x16& p0, f32x16& p1, float alpha, float& l_reg, bf16x8& pa0, bf16x8& pa1, bf16x8& pa2, bf16x8& pa3) {
#pragma unroll
    for (int r = 0; r < 16; ++r) p1[r] = __builtin_amdgcn_exp2f(p1[r]);
    float ps = 0;
#pragma unroll
    for (int r = 0; r < 16; ++r) ps += p0[r];
#pragma unroll
    for (int r = 0; r < 16; ++r) ps += p1[r];
    ps += __shfl_xor(ps, 32);
    l_reg = l_reg * alpha + ps;
#define MA_PK4(P, BASE, OUT) do { unsigned a0 = cvt_pk_bf16(P[BASE + 0], P[BASE + 1]), a1 = cvt_pk_bf16(P[BASE + 2], P[BASE + 3]);   \
    unsigned b0 = cvt_pk_bf16(P[BASE + 4], P[BASE + 5]), b1 = cvt_pk_bf16(P[BASE + 6], P[BASE + 7]);                              \
    auto r0 = __builtin_amdgcn_permlane32_swap(a0, b0, false, false); auto r1 = __builtin_amdgcn_permlane32_swap(a1, b1, false, false); \
    v4u w = {r0[0], r1[0], r0[1], r1[1]}; OUT = as_bf16x8(w); } while (0)
    MA_PK4(p0, 0, pa0); MA_PK4(p0, 8, pa1); MA_PK4(p1, 0, pa2); MA_PK4(p1, 8, pa3);
#undef MA_PK4
}
__device__ __forceinline__ void qkt(f32x16& p0, f32x16& p1, const LAS unsigned char* Ks, const bf16x8* qr, int r32, int hi) {
#pragma unroll
    for (int r = 0; r < 16; ++r) { p0[r] = 0.f; p1[r] = 0.f; }
#pragma unroll
    for (int d0 = 0; d0 < 8; ++d0) { const int cb = (d0 * 16 + hi * 8) * 2;
        const bf16x8 b0 = *(const LAS bf16x8*)(Ks + MA_KSWZ(r32, cb));
        const bf16x8 b1 = *(const LAS bf16x8*)(Ks + MA_KSWZ(32 + r32, cb));
        p0 = MFMA32(b0, qr[d0], p0);
        p1 = MFMA32(b1, qr[d0], p1); }
}
__device__ __forceinline__ int v_st(int k, int c) { const int kk = (k & ~0xC) | ((k & 4) << 1) | ((k & 8) >> 1); return ((kk >> 3) * 4 + (c >> 5)) * 512 + ((kk & 7) * 32 + (c & 31)) * 2; }
__device__ __forceinline__ int v_rd_base(int lane) { return ((lane & 3) << 3) | (((lane >> 2) & 3) << 6) | (((lane >> 4) & 1) << 5) | (((lane >> 5) & 1) << 8); }
constexpr int v_rd_off(int d0, int ks, int half) { return d0 * 512 + ks * 4096 + half * 2048; }
template <int OFF> __device__ __forceinline__ s16x4 tr_read(int vb) {
    s16x4 r; asm volatile("ds_read_b64_tr_b16 %0, %1 offset:%2" : "=&v"(r) : "v"(vb), "i"(OFF) : "memory"); return r;
}
template <int D0> __device__ __forceinline__ void pv_one(f32x16& od, int vb, bf16x8 pa0, bf16x8 pa1, bf16x8 pa2, bf16x8 pa3) {
    const s16x4 l0 = tr_read<v_rd_off(D0, 0, 0)>(vb), h0 = tr_read<v_rd_off(D0, 0, 1)>(vb), l1 = tr_read<v_rd_off(D0, 1, 0)>(vb), h1 = tr_read<v_rd_off(D0, 1, 1)>(vb);
    const s16x4 l2 = tr_read<v_rd_off(D0, 2, 0)>(vb), h2 = tr_read<v_rd_off(D0, 2, 1)>(vb), l3 = tr_read<v_rd_off(D0, 3, 0)>(vb), h3 = tr_read<v_rd_off(D0, 3, 1)>(vb);
    asm volatile("s_waitcnt lgkmcnt(0)" ::: "memory"); MA_SBAR();
#define MA_PK(L, H) (bf16x8){L[0], L[1], L[2], L[3], H[0], H[1], H[2], H[3]}
    od = MFMA32(pa0, MA_PK(l0, h0), od);
    od = MFMA32(pa1, MA_PK(l1, h1), od);
    od = MFMA32(pa2, MA_PK(l2, h2), od);
    od = MFMA32(pa3, MA_PK(l3, h3), od);
#undef MA_PK
}
__device__ __forceinline__ void pv_d0(f32x16* o, int vb, bf16x8 pa0, bf16x8 pa1, bf16x8 pa2, bf16x8 pa3) {
    pv_one<0>(o[0], vb, pa0, pa1, pa2, pa3); pv_one<1>(o[1], vb, pa0, pa1, pa2, pa3); pv_one<2>(o[2], vb, pa0, pa1, pa2, pa3); pv_one<3>(o[3], vb, pa0, pa1, pa2, pa3);
}
__device__ __forceinline__ void body(const bf16* __restrict__ Qb, const bf16* __restrict__ Kh, const bf16* __restrict__ Vh, bf16* __restrict__ Ob, const float* qw, const float* kw, LAS unsigned char* lds) {
    const int tid = threadIdx.x, wid = tid >> 6, lane = tid & 63, r32 = lane & 31, hi = lane >> 5;
    LAS unsigned char* V_lds = lds; LAS unsigned char* K_lds = lds + 2 * SHM_V;
    LAS float* wsl = (LAS float*)(lds + 2 * SHM_V + 2 * SHM_K) + wid * 64; LAS float* li_l = wsl; LAS float* al_l = wsl + 32;
    float m_reg = -1e30f, l_reg = 0; f32x16 o[4]; bf16x8 qr[8];
#pragma unroll
    for (int d = 0; d < 4; ++d)
#pragma unroll
        for (int r = 0; r < 16; ++r) o[d][r] = 0.f;
    { const bf16* Qw = Qb + (size_t)(wid * 32 + r32) * LDQ + hi * 8; v4u raw[8]; float ss = 0.f;
#pragma unroll
      for (int d0 = 0; d0 < 8; ++d0) { raw[d0] = *(const GAS v4u*)(Qw + d0 * 16); float f[8]; unpack8(raw[d0], f);
#pragma unroll
          for (int e = 0; e < 8; ++e) ss += f[e] * f[e]; }
      ss += __shfl_xor(ss, 32);
      const float rstd = 1.f / sqrtf(ss * (1.f / 128.f) + EPS);
#pragma unroll
      for (int d0 = 0; d0 < 8; ++d0) { float f[8]; unpack8(raw[d0], f); const f32x4 w0 = *(const GAS f32x4*)(qw + d0 * 16 + hi * 8), w1 = *(const GAS f32x4*)(qw + d0 * 16 + hi * 8 + 4);
#pragma unroll
          for (int e = 0; e < 4; ++e) { f[e] *= rstd * w0[e]; f[4 + e] *= rstd * w1[e]; }
          qr[d0] = as_bf16x8(pack8(f)); } }
    const int sr = tid >> 4, sc = (tid & 15) * 8, vst0 = v_st(sr, sc), vst1 = v_st(32 + sr, sc);
    const int vb0 = (int)(uintptr_t)V_lds + v_rd_base(lane);
    const f32x4 kw0 = *(const GAS f32x4*)(kw + sc), kw1 = *(const GAS f32x4*)(kw + sc + 4);
    v4u s_vs0[2], s_vs1[2], s_ks0[2], s_ks1[2];
#define MA_SLOAD(i, k0) do { s_vs0[i] = *(const GAS v4u*)(&Vh[(size_t)((k0) + sr) * LDK + sc]); s_vs1[i] = *(const GAS v4u*)(&Vh[(size_t)((k0) + 32 + sr) * LDK + sc]); \
    s_ks0[i] = *(const GAS v4u*)(&Kh[(size_t)((k0) + sr) * LDK + sc]); s_ks1[i] = *(const GAS v4u*)(&Kh[(size_t)((k0) + 32 + sr) * LDK + sc]); } while (0)
#define MA_KNORM(x) ({ float f_[8]; unpack8((x), f_); float ss_ = 0.f; _Pragma("unroll") for (int e_ = 0; e_ < 8; ++e_) ss_ += f_[e_] * f_[e_]; \
    ss_ += __shfl_xor(ss_, 1); ss_ += __shfl_xor(ss_, 2); ss_ += __shfl_xor(ss_, 4); ss_ += __shfl_xor(ss_, 8); const float rs_ = 1.f / sqrtf(ss_ * (1.f / 128.f) + EPS); \
    _Pragma("unroll") for (int e_ = 0; e_ < 4; ++e_) { f_[e_] *= rs_ * kw0[e_]; f_[4 + e_] *= rs_ * kw1[e_]; } pack8(f_); })
#define MA_SWRITE(b, i) do { *(LAS v4u*)(V_lds + (b) * SHM_V + vst0) = s_vs0[i];          \
    *(LAS v4u*)(V_lds + (b) * SHM_V + vst1) = s_vs1[i]; const int kc = sc * 2;               \
    *(LAS v4u*)(K_lds + (b) * SHM_K + MA_KSWZ(sr, kc)) = MA_KNORM(s_ks0[i]);                       \
    *(LAS v4u*)(K_lds + (b) * SHM_K + MA_KSWZ(32 + sr, kc)) = MA_KNORM(s_ks1[i]); } while (0)
#define MA_SWAIT() asm volatile("s_waitcnt vmcnt(4)" ::: "memory")
#define MA_RESC(a) do { if (__any((a) < 1.f)) { if (hi == 0) al_l[r32] = (a); asm volatile("s_waitcnt lgkmcnt(0)" ::: "memory"); \
    _Pragma("unroll") for (int d = 0; d < 4; ++d) _Pragma("unroll") for (int r = 0; r < 16; ++r) o[d][r] *= al_l[crow(r, hi)]; } } while (0)
    f32x16 pA0, pA1, pB0, pB1; float mnA, mnB, alA, alB; bf16x8 pa0, pa1, pa2, pa3; constexpr int NT = MEMLEN / KVBLK;
    MA_SLOAD(0, 0); asm volatile("s_waitcnt vmcnt(0)" ::: "memory"); MA_SWRITE(0, 0); __syncthreads();
    qkt(pA0, pA1, K_lds, qr, r32, hi); partialSM(pA0, pA1, m_reg, mnA, alA);
    MA_SLOAD(1, KVBLK); MA_SLOAD(0, 2 * KVBLK);
    MA_SWAIT(); MA_SWRITE(1, 1); __syncthreads();
#pragma unroll 1
    for (int j = 1; j + 1 < NT; j += 2) {
        MA_SBAR(); qkt(pB0, pB1, K_lds + SHM_K, qr, r32, hi);
        finishSM(pA0, pA1, alA, l_reg, pa0, pa1, pa2, pa3); MA_SBAR();
        MA_SLOAD(1, (j + 2) * KVBLK); MA_SBAR();
        pv_d0(o, vb0, pa0, pa1, pa2, pa3); partialSM(pB0, pB1, m_reg, mnB, alB);
        __syncthreads(); MA_SWAIT(); MA_SWRITE(0, 0);
        MA_RESC(alB); __syncthreads();
        MA_SBAR(); qkt(pA0, pA1, K_lds, qr, r32, hi);
        finishSM(pB0, pB1, alB, l_reg, pa0, pa1, pa2, pa3); MA_SBAR();
        if (j + 3 < NT) MA_SLOAD(0, (j + 3) * KVBLK);
        MA_SBAR();
        pv_d0(o, vb0 + SHM_V, pa0, pa1, pa2, pa3); partialSM(pA0, pA1, m_reg, mnA, alA);
        __syncthreads(); asm volatile("s_waitcnt vmcnt(0)" ::: "memory"); MA_SWRITE(1, 1);
        MA_RESC(alA); __syncthreads();
    }
    MA_SBAR(); qkt(pB0, pB1, K_lds + SHM_K, qr, r32, hi);
    finishSM(pA0, pA1, alA, l_reg, pa0, pa1, pa2, pa3); MA_SBAR();
    pv_d0(o, vb0, pa0, pa1, pa2, pa3); partialSM(pB0, pB1, m_reg, mnB, alB);
    __syncthreads(); MA_RESC(alB);
    finishSM(pB0, pB1, alB, l_reg, pa0, pa1, pa2, pa3); MA_SBAR();
    pv_d0(o, vb0 + SHM_V, pa0, pa1, pa2, pa3);
    if (hi == 0) li_l[r32] = l_reg; asm volatile("s_waitcnt lgkmcnt(0)" ::: "memory");
    float rli[16];
#pragma unroll
    for (int r = 0; r < 16; ++r) rli[r] = __builtin_amdgcn_rcpf(li_l[crow(r, hi)]);
    bf16* Ow = Ob + (size_t)(wid * 32) * LDO;
#pragma unroll
    for (int r = 0; r < 16; ++r) { const int orow = crow(r, hi);
#pragma unroll
        for (int d0 = 0; d0 < 4; ++d0) Ow[(size_t)orow * LDO + d0 * 32 + r32] = (bf16)(cvt_pk_bf16(o[d0][r] * rli[r], 0.f) & 0xffffu); }
    __syncthreads();
#undef MA_SLOAD
#undef MA_SWRITE
#undef MA_SWAIT
#undef MA_RESC
#undef MA_KNORM
}
}

__device__ __forceinline__ void ret_out_unit(Frame& F, const Args& a, int unit) {
    const int b = unit >> 6, h = (unit >> 4) & 3, c = unit & 15;
    const bf16* Z = (const bf16*)(F.ws + WS_Z); bf16* OCb = (bf16*)(F.ws + WS_OC);
    const float* rc = (const float*)(F.ws + WS_ROPE); const float* rs = rc + SEQ * 64;
    const bf16* ST = (const bf16*)(F.ws + WS_ST) + (size_t)((b * 4 + h) * 16 + c) * 256 * 128;
    const float l2g = ret_log2g(h);
    LAS unsigned char* Ql = F.lds; LAS unsigned char* Kl = F.lds + 34816; LAS unsigned char* Vt = F.lds + 69632; LAS f32x2* stats = (LAS f32x2*)(F.lds + 139264); LAS unsigned char* Ost = F.lds;
    { const int m = F.tid >> 2, cg = F.tid & 3; const size_t row = (size_t)(b * SEQ + c * 128 + m);
      const float* cs = rc + (size_t)(c * 128 + m) * 64 + cg * 16; const float* sn = rs + (size_t)(c * 128 + m) * 64 + cg * 16;
      { const bf16* qp = Z + row * INW + C_RQ + h * 128 + cg * 16; float o1[16], o2[16];
        rot16(*(const GAS v4u*)qp, *(const GAS v4u*)(qp + 8), *(const GAS v4u*)(qp + 64), *(const GAS v4u*)(qp + 72), cs, sn, 1.f, o1, o2);
        float t[8];
#pragma unroll
        for (int q = 0; q < 2; ++q) {
#pragma unroll
            for (int e = 0; e < 8; ++e) t[e] = o1[8 * q + e];
            *(LAS v4u*)(Ql + m * 272 + (cg * 16 + 8 * q) * 2) = pack8(t);
#pragma unroll
            for (int e = 0; e < 8; ++e) t[e] = o2[8 * q + e];
            *(LAS v4u*)(Ql + m * 272 + (64 + cg * 16 + 8 * q) * 2) = pack8(t); } }
      { const bf16* kp = Z + row * INW + C_RK + h * 128 + cg * 16; float o1[16], o2[16];
        rot16(*(const GAS v4u*)kp, *(const GAS v4u*)(kp + 8), *(const GAS v4u*)(kp + 64), *(const GAS v4u*)(kp + 72), cs, sn, 0.08838834764831845f, o1, o2);
        float t[8];
#pragma unroll
        for (int q = 0; q < 2; ++q) {
#pragma unroll
            for (int e = 0; e < 8; ++e) t[e] = o1[8 * q + e];
            *(LAS v4u*)(Kl + m * 272 + (cg * 16 + 8 * q) * 2) = pack8(t);
#pragma unroll
            for (int e = 0; e < 8; ++e) t[e] = o2[8 * q + e];
            *(LAS v4u*)(Kl + m * 272 + (64 + cg * 16 + 8 * q) * 2) = pack8(t); } }
      const bf16* vp = Z + row * INW + C_RV + h * 256 + cg * 64;
#pragma unroll
      for (int q = 0; q < 8; ++q) { const v4u vv = *(const GAS v4u*)(vp + 8 * q); const unsigned vw[4] = {vv.x, vv.y, vv.z, vv.w};
#pragma unroll
          for (int e = 0; e < 4; ++e) { st16(Vt + (cg * 64 + 8 * q + 2 * e) * 272 + m * 2, (unsigned short)vw[e]); st16(Vt + (cg * 64 + 8 * q + 2 * e + 1) * 272 + m * 2, (unsigned short)(vw[e] >> 16)); } } }
    __syncthreads();
    const int lb = F.wave & 3, dh = F.wave >> 2, r = F.lane & 31, hh = F.lane >> 5, l = 32 * lb + r;
    bf16x8 qb[8];
#pragma unroll
    for (int ks = 0; ks < 8; ++ks) qb[ks] = *(const LAS bf16x8*)(Ql + l * 272 + (ks * 16 + 8 * hh) * 2);
    f32x16 o[4];
#pragma unroll
    for (int dt = 0; dt < 4; ++dt)
#pragma unroll
        for (int i = 0; i < 16; ++i) o[dt][i] = 0.f;
    if (c > 0) {
#pragma unroll
        for (int dt = 0; dt < 4; ++dt) { const bf16* sp = ST + (size_t)(dh * 128 + 32 * dt + r) * 128 + 8 * hh;
#pragma unroll
            for (int ks = 0; ks < 8; ++ks) { const bf16x8 af = as_bf16x8(*(const GAS v4u*)(sp + ks * 16)); o[dt] = MFMA32(af, qb[ks], o[dt]); } }
        const float qd = exp2f((float)(l + 1) * l2g);
#pragma unroll
        for (int dt = 0; dt < 4; ++dt)
#pragma unroll
            for (int i = 0; i < 16; ++i) o[dt][i] *= qd;
    }
#pragma unroll 1
    for (int mb = 0; mb <= lb; ++mb) {
        f32x16 s;
#pragma unroll
        for (int i = 0; i < 16; ++i) s[i] = 0.f;
#pragma unroll
        for (int ks = 0; ks < 8; ++ks) { const bf16x8 af = *(const LAS bf16x8*)(Kl + (32 * mb + r) * 272 + (ks * 16 + 8 * hh) * 2); s = MFMA32(af, qb[ks], s); }
#pragma unroll
        for (int i = 0; i < 16; ++i) { const int m = 32 * mb + crow(i, hh); s[i] = (l >= m) ? s[i] * exp2f((float)(l - m) * l2g) : 0.f; }
#pragma unroll
        for (int s2 = 0; s2 < 2; ++s2) { v4u pw; pw.x = cvt_pk_bf16(s[8 * s2 + 0], s[8 * s2 + 1]); pw.y = cvt_pk_bf16(s[8 * s2 + 2], s[8 * s2 + 3]); pw.z = cvt_pk_bf16(s[8 * s2 + 4], s[8 * s2 + 5]); pw.w = cvt_pk_bf16(s[8 * s2 + 6], s[8 * s2 + 7]);
            const bf16x8 pf = as_bf16x8(pw);
#pragma unroll
            for (int dt = 0; dt < 4; ++dt) { const LAS unsigned char* vr = Vt + (dh * 128 + 32 * dt + r) * 272 + (32 * mb + 16 * s2 + 4 * hh) * 2;
                const v2u lo = *(const LAS v2u*)vr, hi = *(const LAS v2u*)(vr + 16);
                o[dt] = MFMA32(as_bf16x8((v4u){lo.x, lo.y, hi.x, hi.y}), pf, o[dt]); } }
    }
    float sm = 0.f, sq = 0.f;
#pragma unroll
    for (int dt = 0; dt < 4; ++dt)
#pragma unroll
        for (int i = 0; i < 16; ++i) { sm += o[dt][i]; sq += o[dt][i] * o[dt][i]; }
    sm += __shfl_xor(sm, 32); sq += __shfl_xor(sq, 32);
    if (hh == 0) stats[dh * 128 + l] = (f32x2){sm, sq};
    __syncthreads();
    { const f32x2 s0 = stats[l], s1 = stats[128 + l]; const float mean = (s0.x + s1.x) * (1.f / 256.f); const float var = fmaxf((s0.y + s1.y) * (1.f / 256.f) - mean * mean, 0.f);
      const float rstd = 1.f / sqrtf(var + EPS); const float* nw = a.in[8] + h * 256 + dh * 128;
#pragma unroll
      for (int dt = 0; dt < 4; ++dt)
#pragma unroll
          for (int gq = 0; gq < 4; ++gq) { const int dvl = 32 * dt + 8 * gq + 4 * hh; const f32x4 w4 = *(const GAS f32x4*)(nw + dvl);
              v2u w; w.x = cvt_pk_bf16((o[dt][4 * gq] - mean) * rstd * w4[0], (o[dt][4 * gq + 1] - mean) * rstd * w4[1]); w.y = cvt_pk_bf16((o[dt][4 * gq + 2] - mean) * rstd * w4[2], (o[dt][4 * gq + 3] - mean) * rstd * w4[3]);
              *(LAS v2u*)(Ost + l * 528 + (dh * 128 + dvl) * 2) = w; } }
    __syncthreads();
#pragma unroll
    for (int i = 0; i < 8; ++i) { const int id = F.tid + 512 * i, row = id >> 5, ch = id & 31; const size_t grow = (size_t)(b * SEQ + c * 128 + row);
        const v4u ov = *(const LAS v4u*)(Ost + row * 528 + ch * 16); const v4u gv = *(const GAS v4u*)(Z + grow * INW + C_RG + h * 256 + ch * 8);
        float fo[8], fg[8]; unpack8(ov, fo); unpack8(gv, fg);
#pragma unroll
        for (int e = 0; e < 8; ++e) fo[e] *= fg[e] * sigmoidf_(fg[e]);
        *(GAS v4u*)(OCb + grow * OC + 512 + h * 256 + ch * 8) = pack8(fo); }
    __syncthreads();
}


struct P4Policy {
    typedef f32x4 AccT;
    static constexpr bool PERM = true, GATHER = false, HAS_MID = true;
    int K, G, c; const bf16 *OCb, *Wbr, *Z; bf16* MG;
    __device__ __forceinline__ bool next(int i, Unit& u) const { u.e = 0; return pg8::static_order(i * G + c, T / 256, 4, u.pm, u.pn); }
    __device__ __forceinline__ const char* a_base(const Unit& u) const { return (const char*)OCb + (size_t)u.pm * 256 * OC * 2; }
    __device__ __forceinline__ const char* b_base(const Unit& u) const { return (const char*)Wbr + (size_t)u.pn * 256 * OC * 2; }
    __device__ __forceinline__ void a_off(const Unit&, int, unsigned (&)[2][2]) const {}
    __device__ __forceinline__ void mid(f32x4 (&acc)[2][2][4][2], const Unit& u, int t, int wr, int wc, int fr, int fq) const {
        if (t != 8 && t != 24) return;
        const int br = (t == 8) ? 0 : 1;
        const bf16* zb = Z + (size_t)(u.pm * 256 + wr * 64 + fr) * INW + C_ZG + br * 1024 + u.pn * 256 + wc * 32 + 8 * fq;
#pragma unroll
        for (int ai = 0; ai < 2; ++ai) { v4u ga[4][2], gb[4][2];
#pragma unroll
            for (int m = 0; m < 4; ++m)
#pragma unroll
                for (int bj = 0; bj < 2; ++bj) { const bf16* zr = zb + (size_t)(ai * 128 + m * 16) * INW + bj * 128; ga[m][bj] = *(const GAS v4u*)zr; gb[m][bj] = *(const GAS v4u*)(zr + 1024); }
#pragma unroll
            for (int m = 0; m < 4; ++m)
#pragma unroll
                for (int bj = 0; bj < 2; ++bj) { float fa[8], fb[8]; unpack8(ga[m][bj], fa); unpack8(gb[m][bj], fb); float rt[8];
#pragma unroll
                    for (int e = 0; e < 8; ++e) rt[e] = (1.f + __expf(-fb[e])) * __builtin_amdgcn_rcpf(1.f + __expf(-fa[e]));
                    acc[ai][bj][m][0] *= (f32x4){rt[0], rt[1], rt[2], rt[3]}; acc[ai][bj][m][1] *= (f32x4){rt[4], rt[5], rt[6], rt[7]}; }
            asm volatile("" ::: "memory"); }
    }
    __device__ __forceinline__ void epi(f32x4 (&acc)[2][2][4][2], const Unit& u, int wr, int wc, int fr, int fq) const {
        const bf16* zb = Z + (size_t)(u.pm * 256 + wr * 64 + fr) * INW + C_ZG + 2 * 1024 + u.pn * 256 + wc * 32 + 8 * fq;
        bf16* ob = MG + (size_t)(u.pm * 256 + wr * 64 + fr) * D + u.pn * 256 + wc * 32 + 8 * fq;
#pragma unroll
        for (int ai = 0; ai < 2; ++ai) { v4u ga[4][2];
#pragma unroll
            for (int m = 0; m < 4; ++m)
#pragma unroll
                for (int bj = 0; bj < 2; ++bj) ga[m][bj] = *(const GAS v4u*)(zb + (size_t)(ai * 128 + m * 16) * INW + bj * 128);
#pragma unroll
            for (int m = 0; m < 4; ++m)
#pragma unroll
                for (int bj = 0; bj < 2; ++bj) { float fa[8]; unpack8(ga[m][bj], fa); float r[8];
#pragma unroll
                    for (int e = 0; e < 4; ++e) { r[e] = acc[ai][bj][m][0][e] * sigmoidf_(fa[e]); r[4 + e] = acc[ai][bj][m][1][e] * sigmoidf_(fa[4 + e]); }
                    *(GAS v4u*)(ob + (size_t)(ai * 128 + m * 16) * D + bj * 128) = pack8(r); }
            asm volatile("" ::: "memory"); }
    }
};
struct P5Policy {
    typedef f32x4 AccT;
    static constexpr bool PERM = false, GATHER = false, HAS_MID = false;
    int K, G, c; const bf16 *MG, *Wout; const float* X; float* OUT;
    __device__ __forceinline__ bool next(int i, Unit& u) const { u.e = 0; return pg8::static_order(i * G + c, T / 256, 4, u.pm, u.pn); }
    __device__ __forceinline__ const char* a_base(const Unit& u) const { return (const char*)MG + (size_t)u.pm * 256 * D * 2; }
    __device__ __forceinline__ const char* b_base(const Unit& u) const { return (const char*)Wout + (size_t)u.pn * 256 * D * 2; }
    __device__ __forceinline__ void a_off(const Unit&, int, unsigned (&)[2][2]) const {}
    __device__ __forceinline__ void mid(f32x4 (&)[2][2][4][2], const Unit&, int, int, int, int, int) const {}
    __device__ __forceinline__ void epi(f32x4 (&acc)[2][2][4][2], const Unit& u, int wr, int wc, int fr, int fq) const {
        const size_t off0 = (size_t)(u.pm * 256 + wr * 64 + fr) * D + u.pn * 256 + wc * 32 + 4 * fq;
#pragma unroll
        for (int ai = 0; ai < 2; ++ai) { f32x4 xv[4][2][2];
#pragma unroll
            for (int m = 0; m < 4; ++m)
#pragma unroll
                for (int bj = 0; bj < 2; ++bj)
#pragma unroll
                    for (int n = 0; n < 2; ++n) xv[m][bj][n] = *(const GAS f32x4*)(X + off0 + (size_t)(ai * 128 + m * 16) * D + bj * 128 + n * 16);
#pragma unroll
            for (int m = 0; m < 4; ++m)
#pragma unroll
                for (int bj = 0; bj < 2; ++bj)
#pragma unroll
                    for (int n = 0; n < 2; ++n) *(GAS f32x4*)(OUT + off0 + (size_t)(ai * 128 + m * 16) * D + bj * 128 + n * 16) = xv[m][bj][n] + acc[ai][bj][m][n];
            asm volatile("" ::: "memory"); }
    }
};
__device__ __forceinline__ void p6_router(Frame& F, const Args& a) {
    LAS float* Xs = (LAS float*)F.lds; LAS float* Pp = (LAS float*)F.lds; LAS float* Lg = (LAS float*)(F.lds + 132096); LAS float* rstd_s = (LAS float*)(F.lds + 136320);
    LAS int* sel_e = (LAS int*)(F.lds + 136448); LAS float* sel_g = (LAS float*)(F.lds + 138496); LAS int* sel_p = (LAS int*)(F.lds + 140544); LAS float* sel_s = (LAS float*)(F.lds + 142592);
    LAS int* lcnt = (LAS int*)(F.lds + 143104); LAS int* lbase = (LAS int*)(F.lds + 143232);
    const float* wrt = (const float*)(F.ws + WS_WR); const float* gain = a.in[16]; const float* brt = a.in[18];
    signed char* H2Q = (signed char*)(F.ws + WS_H); int* list = (int*)(F.ws + WS_LIST); float* lgate = (float*)(F.ws + WS_GATE); float* lscale = (float*)(F.ws + WS_LSC);
    unsigned* gcnt = (unsigned*)(F.ctl + CW_CNT);
    const int lane = F.lane, w = F.wave, hh = lane >> 5, ex = lane & 31;
    float bw[16][4];
#pragma unroll
    for (int q = 0; q < 16; ++q) { const int k0 = 128 * w + 8 * q + 4 * hh; const f32x4 wr4 = *(const GAS f32x4*)(wrt + ex * 1024 + k0), g4 = *(const GAS f32x4*)(gain + k0);
#pragma unroll
        for (int j = 0; j < 4; ++j) bw[q][j] = wr4[j] * g4[j]; }
    f32x4 gn[4];
#pragma unroll
    for (int jj = 0; jj < 4; ++jj) gn[jj] = *(const GAS f32x4*)(gain + 4 * lane + 256 * jj);
    for (int chunk = F.bid; chunk < T / 128; chunk += F.G) {
        if (F.tid < 32) lcnt[F.tid] = 0;
#pragma unroll 1
        for (int ti = 0; ti < 4; ++ti) {
            const int tok0 = chunk * 128 + ti * 32;
#pragma unroll
            for (int j = 0; j < 4; ++j) { const int rl = 4 * w + j; const GAS f32x4* xr = (const GAS f32x4*)(a.out + (size_t)(tok0 + rl) * D) + lane;
                f32x4 x4[4]; float ss = 0.f, am = 0.f;
#pragma unroll
                for (int jj = 0; jj < 4; ++jj) { x4[jj] = xr[64 * jj]; const f32x4 xg = x4[jj] * gn[jj];
                    ss += (x4[jj].x * x4[jj].x + x4[jj].y * x4[jj].y) + (x4[jj].z * x4[jj].z + x4[jj].w * x4[jj].w);
                    am = fmaxf(fmaxf(am, fmaxf(fabsf(xg.x), fabsf(xg.y))), fmaxf(fabsf(xg.z), fabsf(xg.w))); }
#pragma unroll
                for (int o = 1; o < 64; o <<= 1) { ss += __shfl_xor(ss, o); am = fmaxf(am, __shfl_xor(am, o)); }
                const float rstd = 1.f / sqrtf(ss * (1.f / D) + EPS); const float amh = am * rstd; const float qm = amh > 0.f ? rstd * 127.f / amh : 0.f;
                GAS unsigned* oq = (GAS unsigned*)(H2Q + (size_t)(tok0 + rl) * D) + lane;
#pragma unroll
                for (int jj = 0; jj < 4; ++jj) { const f32x4 xg = x4[jj] * gn[jj] * qm;
                    const unsigned q = ((unsigned)(int)rintf(xg.x) & 0xffu) | (((unsigned)(int)rintf(xg.y) & 0xffu) << 8) | (((unsigned)(int)rintf(xg.z) & 0xffu) << 16) | (((unsigned)(int)rintf(xg.w) & 0xffu) << 24);
                    oq[64 * jj] = q; *(LAS f32x4*)(Xs + rl * 1028 + 4 * lane + 256 * jj) = x4[jj]; }
                if (lane == 0) { rstd_s[rl] = rstd; sel_s[ti * 32 + rl] = amh * (1.f / 127.f); } }
            __syncthreads();
            f32x16 acc;
#pragma unroll
            for (int i = 0; i < 16; ++i) acc[i] = 0.f;
#pragma unroll
            for (int q = 0; q < 16; ++q) { const f32x4 a4 = *(const LAS f32x4*)(Xs + ex * 1028 + 128 * w + 8 * q + 4 * hh);
#pragma unroll
                for (int j = 0; j < 4; ++j) acc = __builtin_amdgcn_mfma_f32_32x32x2f32(a4[j], bw[q][j], acc, 0, 0, 0); }
            __syncthreads();
#pragma unroll
            for (int i = 0; i < 16; ++i) Pp[(w * 32 + crow(i, hh)) * 33 + ex] = acc[i];
            __syncthreads();
#pragma unroll
            for (int p2 = 0; p2 < 2; ++p2) { const int pi = F.tid + 512 * p2, i = pi >> 5, e2 = pi & 31; float s = 0.f;
#pragma unroll
                for (int ww = 0; ww < 8; ++ww) s += Pp[(ww * 32 + i) * 33 + e2];
                Lg[i * 33 + e2] = s * rstd_s[i] + brt[e2]; }
            __syncthreads();
            if (F.tid < 32) { const int i = F.tid; float t0 = -3.0e38f, t1 = -3.0e38f, t2 = -3.0e38f, t3 = -3.0e38f; int i0 = 0, i1 = 0, i2 = 0, i3 = 0;
#pragma unroll 1
                for (int e2 = 0; e2 < NE; ++e2) { const float v = Lg[i * 33 + e2];
                    if (v > t3) { if (v > t2) { t3 = t2; i3 = i2; if (v > t1) { t2 = t1; i2 = i1; if (v > t0) { t1 = t0; i1 = i0; t0 = v; i0 = e2; } else { t1 = v; i1 = e2; } } else { t2 = v; i2 = e2; } } else { t3 = v; i3 = e2; } } }
                const float e1 = __expf(t1 - t0), e2x = __expf(t2 - t0), e3 = __expf(t3 - t0); const float inv = 1.f / (1.f + e1 + e2x + e3);
                const int sl = (ti * 32 + i) * 4;
                sel_e[sl] = i0; sel_g[sl] = inv; sel_p[sl] = atomicAdd((int*)(lcnt + i0), 1);
                sel_e[sl + 1] = i1; sel_g[sl + 1] = e1 * inv; sel_p[sl + 1] = atomicAdd((int*)(lcnt + i1), 1);
                sel_e[sl + 2] = i2; sel_g[sl + 2] = e2x * inv; sel_p[sl + 2] = atomicAdd((int*)(lcnt + i2), 1);
                sel_e[sl + 3] = i3; sel_g[sl + 3] = e3 * inv; sel_p[sl + 3] = atomicAdd((int*)(lcnt + i3), 1); }
            __syncthreads();
        }
        if (F.tid < 32) lbase[F.tid] = (int)__hip_atomic_fetch_add(gcnt + F.tid, (unsigned)lcnt[F.tid], RLX_AGENT);
        __syncthreads();
        { const int e2 = sel_e[F.tid]; const size_t pos = (size_t)e2 * LCAP + lbase[e2] + sel_p[F.tid]; const int dest = (chunk * 128 + (F.tid >> 2)) * 4 + (F.tid & 3);
          list[pos] = dest; lgate[pos] = sel_g[F.tid]; lscale[pos] = sel_s[F.tid >> 2]; }
        __syncthreads();
    }
}
__device__ __forceinline__ void moe_table(Frame& F) {
    if (F.tid < 32) F.MISC[64 + F.tid] = __hip_atomic_load(F.ctl + CW_CNT + F.tid, RLX_AGENT);
    __syncthreads();
    if (F.tid == 0) { unsigned s = 0; for (int e = 0; e < NE; ++e) { F.MISC[16 + e] = s; s += (F.MISC[64 + e] + 255u) >> 8; } F.MISC[16 + NE] = s; }
    __syncthreads();
}
template <int NPN>
__device__ __forceinline__ bool moe_next(volatile LAS unsigned* MISC, int L, Unit& u) {
    const int total = (int)MISC[16 + NE] * NPN; if (L >= total) return false;
    const int tile = L / NPN; u.pn = L % NPN; int e = 0;
#pragma unroll 1
    for (int k = 1; k < NE; ++k) e = ((int)MISC[16 + k] <= tile) ? k : e;
    u.e = e; u.pm = tile; u.x = tile - (int)MISC[16 + e]; return true;
}
struct P7Policy {
    typedef v4i AccT;
    static constexpr bool PERM = true, GATHER = true, HAS_MID = false;
    int K, G, c; const signed char *H2Q, *Wup; bf16* ACT; const int* list; const float* lscale; const float* wsc; const float* bup; volatile LAS unsigned* MISC;
    __device__ __forceinline__ bool next(int i, Unit& u) const { return moe_next<8>(MISC, i * G + c, u); }
    __device__ __forceinline__ const char* a_base(const Unit&) const { return (const char*)H2Q; }
    __device__ __forceinline__ const char* b_base(const Unit& u) const { return (const char*)Wup + ((size_t)u.e * 2048 + (size_t)u.pn * 256) * D; }
    __device__ __forceinline__ void a_off(const Unit& u, int tid, unsigned (&v)[2][2]) const {
        const int cnt = (int)MISC[64 + u.e];
#pragma unroll
        for (int i = 0; i < 2; ++i) { int R, C; pg8::stage_rc(tid * 16 + i * 8192, R, C);
#pragma unroll
            for (int h = 0; h < 2; ++h) { const int idx = u.x * 256 + h * 128 + R; const int tok = (idx < cnt) ? (list[(size_t)u.e * LCAP + idx] >> 2) : 0; v[h][i] = (unsigned)tok * (unsigned)D + (unsigned)(C * 2); } }
    }
    __device__ __forceinline__ void mid(AccT (&)[2][2][4][2], const Unit&, int, int, int, int, int) const {}
    __device__ __forceinline__ void epi(AccT (&acc)[2][2][4][2], const Unit& u, int wr, int wc, int fr, int fq) const {
        const int cnt = (int)MISC[64 + u.e];
        const int oc0 = u.pn * 128 + wc * 32 + 8 * fq;
        const float* bp = bup + (size_t)u.e * 2048 + 2 * oc0;
        const float* sp = wsc + (size_t)u.e * 2048 + u.pn * 256 + wc * 32 + 8 * fq;
        f32x4 bb[4], sg[2], sl[2];
#pragma unroll
        for (int q = 0; q < 4; ++q) bb[q] = *(const GAS f32x4*)(bp + 4 * q);
#pragma unroll
        for (int n = 0; n < 2; ++n) { sg[n] = *(const GAS f32x4*)(sp + 4 * n); sl[n] = *(const GAS f32x4*)(sp + 128 + 4 * n); }
        float sa[2][4];
#pragma unroll
        for (int ai = 0; ai < 2; ++ai)
#pragma unroll
            for (int m = 0; m < 4; ++m) { const int idx = u.x * 256 + ai * 128 + wr * 64 + m * 16 + fr; sa[ai][m] = (idx < cnt) ? lscale[(size_t)u.e * LCAP + idx] : 0.f; }
        bf16* ob = ACT + (size_t)(u.pm * 256 + wr * 64 + fr) * DFF + oc0;
#pragma unroll
        for (int ai = 0; ai < 2; ++ai)
#pragma unroll
            for (int m = 0; m < 4; ++m) { float r[8];
#pragma unroll
                for (int n = 0; n < 2; ++n)
#pragma unroll
                    for (int q = 0; q < 4; ++q) { const int j = 4 * n + q;
                        const float bg = bb[(2 * j) >> 2][(2 * j) & 3], bl = bb[(2 * j + 1) >> 2][(2 * j + 1) & 3];
                        const float hg = (float)acc[ai][0][m][n][q] * (sa[ai][m] * sg[n][q]) + bg, hl = (float)acc[ai][1][m][n][q] * (sa[ai][m] * sl[n][q]) + bl;
                        const float xg = fminf(hg, 7.f), xl = fminf(fmaxf(hl, -7.f), 7.f);
                        r[j] = xg * sigmoidf_(1.702f * xg) * (xl + 1.f); }
                *(GAS v4u*)(ob + (size_t)(ai * 128 + m * 16) * DFF) = pack8(r); }
    }
};
struct P8Policy {
    typedef f32x4 AccT;
    static constexpr bool PERM = true, GATHER = false, HAS_MID = false;
    int K, G, c; const bf16 *ACT, *Wdn; bf16* Y; const int* list; const float* gate_tk; const float* bdn; volatile LAS unsigned* MISC;
    __device__ __forceinline__ bool next(int i, Unit& u) const { return moe_next<4>(MISC, i * G + c, u); }
    __device__ __forceinline__ const char* a_base(const Unit& u) const { return (const char*)ACT + (size_t)u.pm * 256 * DFF * 2; }
    __device__ __forceinline__ const char* b_base(const Unit& u) const { return (const char*)Wdn + ((size_t)u.e * 1024 + (size_t)u.pn * 256) * DFF * 2; }
    __device__ __forceinline__ void a_off(const Unit&, int, unsigned (&)[2][2]) const {}
    __device__ __forceinline__ void mid(f32x4 (&)[2][2][4][2], const Unit&, int, int, int, int, int) const {}
    __device__ __forceinline__ void epi(f32x4 (&acc)[2][2][4][2], const Unit& u, int wr, int wc, int fr, int fq) const {
        const int cnt = (int)MISC[64 + u.e]; const int c0 = u.pn * 256 + wc * 32 + 8 * fq;
        f32x4 bb[2][2];
#pragma unroll
        for (int bj = 0; bj < 2; ++bj)
#pragma unroll
            for (int n = 0; n < 2; ++n) bb[bj][n] = *(const GAS f32x4*)(bdn + (size_t)u.e * 1024 + c0 + bj * 128 + 4 * n);
#pragma unroll
        for (int ai = 0; ai < 2; ++ai)
#pragma unroll
            for (int m = 0; m < 4; ++m) { const int idx = u.x * 256 + ai * 128 + wr * 64 + m * 16 + fr;
                if (idx < cnt) { const int dest = list[(size_t)u.e * LCAP + idx]; const float gt = gate_tk[(size_t)u.e * LCAP + idx]; bf16* yp = Y + (size_t)dest * D + c0;
#pragma unroll
                    for (int bj = 0; bj < 2; ++bj) { float r[8];
#pragma unroll
                        for (int q = 0; q < 4; ++q) { r[q] = (acc[ai][bj][m][0][q] + bb[bj][0][q]) * gt; r[4 + q] = (acc[ai][bj][m][1][q] + bb[bj][1][q]) * gt; }
                        *(GAS v4u*)(yp + bj * 128) = pack8(r); } } }
    }
};
__device__ __forceinline__ void p9_combine(Frame& F, const Args& a) {
    const bf16* Y = (const bf16*)(F.ws + WS_Y);
    const int gw = F.bid * NWAVES + F.wave, NGW = F.G * NWAVES;
    for (int t = gw; t < T; t += NGW) {
        GAS f32x4* xr = (GAS f32x4*)(a.out + (size_t)t * D) + F.lane;
        f32x4 v[4];
#pragma unroll
        for (int j = 0; j < 4; ++j) v[j] = xr[64 * j];
#pragma unroll
        for (int k = 0; k < 4; ++k) { const GAS v2u* yr = (const GAS v2u*)(Y + ((size_t)t * 4 + k) * D) + F.lane;
#pragma unroll
            for (int j = 0; j < 4; ++j) { const v2u w = yr[64 * j]; v[j] += (f32x4){bf_lo(w.x), bf_hi(w.x), bf_lo(w.y), bf_hi(w.y)}; } }
#pragma unroll
        for (int j = 0; j < 4; ++j) xr[64 * j] = v[j];
    }
}

__global__ void __launch_bounds__(NWAVES * 64, 2) fwd(Args args) {
    extern __shared__ __attribute__((aligned(16))) unsigned char lds[];
    Frame F;
    F.lds = (LAS unsigned char*)lds;
    F.MISC = (volatile LAS unsigned*)(F.lds + MISC_OFF);
    F.tid = threadIdx.x; F.lane = F.tid & 63; F.wave = __builtin_amdgcn_readfirstlane(F.tid >> 6);
    F.G = gridDim.x; F.bid = blockIdx.x; F.ws = args.ws;
    F.ctl = (gu32*)(args.ws + WS_CTL);
    for (int u = F.tid; u < 256; u += NWAVES * 64) ((LAS unsigned*)(F.lds + MISC_OFF))[u] = 0u;
    __syncthreads();
    const int lo = args.ph_lo, hi = args.ph_hi;
    const bool multi = (hi - lo) > 1;
    XcdBarrier bar; bar.bar = (unsigned*)(F.ctl + CW_BAR) + args.li * XCD_BAR_WORDS; bar.x = 0; bar.st = nullptr;
    if (multi) bar = xcd_barrier_post((unsigned*)(F.ctl + CW_BAR) + args.li * XCD_BAR_WORDS, F.MISC);
#define IN(k) (lo <= (k) && (k) < hi)
#define SEAM(k) do { if (IN(k) && IN((k) + 1)) xcd_barrier(bar); } while (0)

    if (IN(0)) { p0_prologue(F, args); }
    SEAM(0);
    if (IN(1)) {
        P1Policy p; p.K = D; p.G = F.G; p.c = F.bid; p.H = (const bf16*)(F.ws + WS_H); p.MB = (const bf16*)(F.ws + WS_MB); p.Win = (const bf16*)(F.ws + WS_WIN); p.Wmkv = (const bf16*)(F.ws + WS_WMKV);
        p.Z = (bf16*)(F.ws + WS_Z); p.MKV = (bf16*)(F.ws + WS_MKV);
        pg8::gemm_phase(F.lds, p);
    }
    SEAM(1);
    if (IN(2)) {
        for (int u = F.bid; u < 256; u += F.G) ret_scan_unit(F, u);
        for (int u = F.bid; u < 1024; u += F.G) swa_unit(F, args, u);
        for (int u = F.bid; u < 512; u += F.G) { const int b = u >> 5, h = (u >> 3) & 3, qb = u & 7;
            const bf16* Z = (const bf16*)(F.ws + WS_Z); const bf16* MKV = (const bf16*)(F.ws + WS_MKV); bf16* OCb = (bf16*)(F.ws + WS_OC);
            ma::body(Z + (size_t)(b * SEQ + qb * 256) * INW + C_MQ + h * 128, MKV + (size_t)(b * MEMLEN) * 1024 + h * 128, MKV + (size_t)(b * MEMLEN) * 1024 + 512 + h * 128,
                     OCb + (size_t)(b * SEQ + qb * 256) * OC + 1536 + h * 128, args.in[10], args.in[11], F.lds); }
    }
    SEAM(2);
    if (IN(3)) { for (int u = F.bid; u < 1024; u += F.G) ret_out_unit(F, args, u); }
    SEAM(3);
    if (IN(4)) {
        P4Policy p; p.K = OC; p.G = F.G; p.c = F.bid; p.OCb = (const bf16*)(F.ws + WS_OC); p.Wbr = (const bf16*)(F.ws + WS_WBR); p.Z = (const bf16*)(F.ws + WS_Z); p.MG = (bf16*)(F.ws + WS_H);
        pg8::gemm_phase(F.lds, p);
    }
    SEAM(4);
    if (IN(5)) {
        P5Policy p; p.K = D; p.G = F.G; p.c = F.bid; p.MG = (const bf16*)(F.ws + WS_H); p.Wout = (const bf16*)(F.ws + WS_WOUT); p.X = args.in[0]; p.OUT = args.out;
        pg8::gemm_phase(F.lds, p);
    }
    SEAM(5);
    if (IN(6)) { p6_router(F, args); }
    SEAM(6);
    if (IN(7)) {
        moe_table(F);
        P7Policy p; p.K = D / 2; p.G = F.G; p.c = F.bid; p.H2Q = (const signed char*)(F.ws + WS_H); p.Wup = (const signed char*)(F.ws + WS_WUP); p.ACT = (bf16*)(F.ws + WS_ACT); p.list = (const int*)(F.ws + WS_LIST);
        p.lscale = (const float*)(F.ws + WS_LSC); p.wsc = (const float*)(F.ws + WS_WSC); p.bup = args.in[20]; p.MISC = F.MISC;
        pg8::gemm_phase(F.lds, p);
    }
    SEAM(7);
    if (IN(8)) {
        moe_table(F);
        P8Policy p; p.K = DFF; p.G = F.G; p.c = F.bid; p.ACT = (const bf16*)(F.ws + WS_ACT); p.Wdn = (const bf16*)(F.ws + WS_WDN); p.Y = (bf16*)(F.ws + WS_Y); p.list = (const int*)(F.ws + WS_LIST);
        p.gate_tk = (const float*)(F.ws + WS_GATE); p.bdn = args.in[22]; p.MISC = F.MISC;
        pg8::gemm_phase(F.lds, p);
    }
    SEAM(8);
    if (IN(9)) { p9_combine(F, args); }
#undef IN
#undef SEAM
}

extern "C" void kernel_launch(void* const* d_in, const int* in_sizes, int n_in, void* d_out, int out_size, void* d_ws, size_t ws_size, hipStream_t stream) {
    static int grid = 0;
    if (grid == 0) {
        if (n_in != 23 || out_size != T * D || ws_size < WS_END) { fprintf(stderr, "kernel_launch: unexpected shapes (n_in %d out %d ws %zu)\n", n_in, out_size, ws_size); grid = -1; return; }
        int dev = 0, cus = 0;
        if (hipGetDevice(&dev) != hipSuccess || hipDeviceGetAttribute(&cus, hipDeviceAttributeMultiprocessorCount, dev) != hipSuccess) { grid = -1; return; }
        if (hipFuncSetAttribute((const void*)fwd, hipFuncAttributeMaxDynamicSharedMemorySize, LDS_BYTES) != hipSuccess) { fprintf(stderr, "kernel_launch: hipFuncSetAttribute failed\n"); grid = -1; return; }
        int per_cu = 0;
        if (hipOccupancyMaxActiveBlocksPerMultiprocessor(&per_cu, (const void*)fwd, NWAVES * 64, LDS_BYTES) != hipSuccess || per_cu < 1) fprintf(stderr, "kernel_launch: occupancy query reports %d\n", per_cu);
        (void)hipGetLastError();
        grid = cus;
    }
    if (grid < 0) return;
    (void)hipMemsetAsync((char*)d_ws + WS_CTL, 0, CTL_ZERO_BYTES, stream);
    Args a{};
    for (int i = 0; i < 23; ++i) a.in[i] = (const float*)d_in[i];
    a.out = (float*)d_out; a.ws = (unsigned char*)d_ws;
#if PROBE_DUP >= 0
    a.ph_lo = 0; a.ph_hi = PROBE_DUP + 1; a.li = 0; hipLaunchKernelGGL(fwd, dim3(grid), dim3(NWAVES * 64), LDS_BYTES, stream, a);
    if (PROBE_DUP == 6) (void)hipMemsetAsync((char*)d_ws + WS_CTL + CW_CNT * 4, 0, 128, stream);
    a.ph_lo = PROBE_DUP; a.ph_hi = PROBE_DUP + 1; a.li = 1; hipLaunchKernelGGL(fwd, dim3(grid), dim3(NWAVES * 64), LDS_BYTES, stream, a);
    if (PROBE_DUP + 1 < 10) { a.ph_lo = PROBE_DUP + 1; a.ph_hi = 10; a.li = 2; hipLaunchKernelGGL(fwd, dim3(grid), dim3(NWAVES * 64), LDS_BYTES, stream, a); }
#else
    a.ph_lo = 0; a.ph_hi = 10; a.li = 0;
    hipLaunchKernelGGL(fwd, dim3(grid), dim3(NWAVES * 64), LDS_BYTES, stream, a);
#endif
}
```
